# Optimizing an MI355X kernel written in HIP

```python
import jax, jax.numpy as jnp
from jax import lax
import numpy as np

D_MODEL = 2048
BATCH = 1
SEQ = 8192
DEPTH = 1
DEC_BATCH = 8
DEC_SEQ = 2048
PAST_LEN = 128

GRID_W = 64
HEAD_DIM = 128
NA_HEADS = 8
NA_WIDTH = NA_HEADS * HEAD_DIM
NA_KH_MAX = 8
NA_KW = 16
GQA_HEADS = 8
GQA_KV_HEADS = 2
GQA_WIDTH = GQA_HEADS * HEAD_DIM
GQA_KV_WIDTH = GQA_KV_HEADS * HEAD_DIM
ROPE_THETA = 10000.0
ROPE_AXIS_DIM = HEAD_DIM // 2
Q_BLOCK = 128
EPS = 1e-6
IN_SIZES = (NA_WIDTH, NA_WIDTH, NA_WIDTH, NA_WIDTH,
            GQA_WIDTH, GQA_KV_WIDTH, GQA_KV_WIDTH, GQA_WIDTH,
            D_MODEL, D_MODEL)
IN_WIDTH = 4 * NA_WIDTH + 2 * GQA_WIDTH + 2 * GQA_KV_WIDTH + 2 * D_MODEL

kernel_name = "hybrid_natten_gqa_gated_encoder"


def _split_points():
    pts = []
    acc = 0
    for s in IN_SIZES[:-1]:
        acc += s
        pts.append(acc)
    return pts


def rmsnorm(x, g):
    xf = x.astype(jnp.float32)
    y = xf * lax.rsqrt(jnp.mean(xf * xf, axis=-1, keepdims=True) + EPS)
    return (y * g.astype(jnp.float32)).astype(x.dtype)


def neighbourhood_attention(q, k, v, rpb):
    B, L, H, Dh = q.shape
    rows = L // GRID_W
    kh = min(NA_KH_MAX, rows)
    qg = q.reshape(B, rows, GRID_W, H, Dh)
    kg = k.reshape(B, rows, GRID_W, H, Dh)
    vg = v.reshape(B, rows, GRID_W, H, Dh)
    col = jnp.arange(GRID_W)
    col_start = jnp.clip(col - NA_KW // 2, 0, GRID_W - NA_KW)
    col_idx = col_start[:, None] + jnp.arange(NA_KW)[None, :]
    dc_idx = col_idx - col[:, None] + (NA_KW - 1)
    scale = Dh ** -0.5

    def one_row(r):
        rs = jnp.clip(r - kh // 2, 0, rows - kh)
        q_r = lax.dynamic_index_in_dim(qg, r, axis=1, keepdims=False)
        k_r = lax.dynamic_slice_in_dim(kg, rs, kh, axis=1)
        v_r = lax.dynamic_slice_in_dim(vg, rs, kh, axis=1)
        k_n = k_r[:, :, col_idx]
        v_n = v_r[:, :, col_idx]
        s = jnp.einsum('bqhd,bjqkhd->bhqjk', q_r, k_n,
                       preferred_element_type=jnp.float32) * scale
        dr_idx = rs + jnp.arange(kh) - r + (NA_KH_MAX - 1)
        bias = rpb[:, dr_idx][:, :, dc_idx]
        s = s + bias.transpose(0, 2, 1, 3).astype(jnp.float32)[None]
        p = jax.nn.softmax(s.reshape(B, H, GRID_W, kh * NA_KW), axis=-1)
        p = p.reshape(B, H, GRID_W, kh, NA_KW).astype(v.dtype)
        return jnp.einsum('bhqjk,bjqkhd->bqhd', p, v_n)

    out = lax.map(one_row, jnp.arange(rows))
    return out.transpose(1, 0, 2, 3, 4).reshape(B, L, H * Dh)


def axial_rope_tables(L):
    t = jnp.arange(L)
    r = (t // GRID_W).astype(jnp.float32)
    c = (t % GRID_W).astype(jnp.float32)
    freqs = ROPE_THETA ** (-jnp.arange(0, ROPE_AXIS_DIM, 2, dtype=jnp.float32) / ROPE_AXIS_DIM)
    ang_r = r[:, None] * freqs[None, :]
    ang_c = c[:, None] * freqs[None, :]
    return jnp.cos(ang_r), jnp.sin(ang_r), jnp.cos(ang_c), jnp.sin(ang_c)


def _rotate(x, cos, sin):
    half = x.shape[-1] // 2
    x1, x2 = x[..., :half], x[..., half:]
    c = cos[None, :, None, :]
    s = sin[None, :, None, :]
    return jnp.concatenate([x1 * c - x2 * s, x2 * c + x1 * s], axis=-1)


def apply_axial_rope(x, tables):
    cos_r, sin_r, cos_c, sin_c = tables
    xf = x.astype(jnp.float32)
    y = jnp.concatenate([_rotate(xf[..., :ROPE_AXIS_DIM], cos_r, sin_r),
                         _rotate(xf[..., ROPE_AXIS_DIM:], cos_c, sin_c)], axis=-1)
    return y.astype(x.dtype)


def gqa_attention(q, k, v):
    B, L, H, Dh = q.shape
    Hkv = k.shape[2]
    G = H // Hkv
    nb = L // Q_BLOCK
    scale = Dh ** -0.5
    qb = q.reshape(B, nb, Q_BLOCK, Hkv, G, Dh).transpose(1, 0, 2, 3, 4, 5)

    def block(q_blk):
        s = jnp.einsum('bqkgd,bskd->bkgqs', q_blk, k,
                       preferred_element_type=jnp.float32) * scale
        p = jax.nn.softmax(s, axis=-1).astype(v.dtype)
        return jnp.einsum('bkgqs,bskd->bqkgd', p, v)

    o = lax.map(block, qb)
    return o.transpose(1, 0, 2, 3, 4, 5).reshape(B, L, H * Dh)


def encoder_layer(x, norm_g, w_in, na_q_g, na_k_g, na_rpb, gq_q_g, gq_k_g,
                  w_branch_a, w_branch_b, gate_bias, w_out):
    B, L, _ = x.shape
    h = rmsnorm(x, norm_g)
    proj = h @ w_in
    (na_q, na_k, na_v, na_z, gq_q, gq_k, gq_v, gq_z,
     g_a, g_b) = jnp.split(proj, _split_points(), axis=-1)

    qa = rmsnorm(na_q.reshape(B, L, NA_HEADS, HEAD_DIM), na_q_g)
    ka = rmsnorm(na_k.reshape(B, L, NA_HEADS, HEAD_DIM), na_k_g)
    va = na_v.reshape(B, L, NA_HEADS, HEAD_DIM)
    oa = neighbourhood_attention(qa, ka, va, na_rpb) * jax.nn.silu(na_z)
    pa = oa @ w_branch_a

    tables = axial_rope_tables(L)
    qb = apply_axial_rope(rmsnorm(gq_q.reshape(B, L, GQA_HEADS, HEAD_DIM), gq_q_g), tables)
    kb = apply_axial_rope(rmsnorm(gq_k.reshape(B, L, GQA_KV_HEADS, HEAD_DIM), gq_k_g), tables)
    vb = gq_v.reshape(B, L, GQA_KV_HEADS, HEAD_DIM)
    ob = gqa_attention(qb, kb, vb) * jax.nn.silu(gq_z)
    pb = ob @ w_branch_b

    ga = jax.nn.sigmoid(g_a + gate_bias[:D_MODEL])
    gb = jax.nn.sigmoid(g_b + gate_bias[D_MODEL:])
    merged = ga * pa + gb * pb
    return x + merged @ w_out


def setup_inputs(seed: int = 0) -> dict:
    key = jax.random.key(seed)
    ks = jax.random.split(key, 16)
    f32 = jnp.float32
    nrm = lambda k, shape, s: (jax.random.normal(k, shape, f32) * s).astype(f32)
    return {
        "x_prompt": nrm(ks[0], (BATCH, SEQ, D_MODEL), 1.0),
        "x_sample": nrm(ks[1], (DEC_BATCH, DEC_SEQ, D_MODEL), 1.0),
        "norm_g": 1.0 + nrm(ks[2], (DEPTH, D_MODEL), 0.02),
        "w_in": nrm(ks[3], (DEPTH, D_MODEL, IN_WIDTH), D_MODEL ** -0.5),
        "na_q_g": 1.0 + nrm(ks[4], (DEPTH, HEAD_DIM), 0.02),
        "na_k_g": 1.0 + nrm(ks[5], (DEPTH, HEAD_DIM), 0.02),
        "na_rpb": nrm(ks[6], (DEPTH, NA_HEADS, 2 * NA_KH_MAX - 1, 2 * NA_KW - 1), 0.1),
        "gq_q_g": 1.0 + nrm(ks[7], (DEPTH, HEAD_DIM), 0.02),
        "gq_k_g": 1.0 + nrm(ks[8], (DEPTH, HEAD_DIM), 0.02),
        "w_branch_a": nrm(ks[9], (DEPTH, NA_WIDTH, D_MODEL), NA_WIDTH ** -0.5),
        "w_branch_b": nrm(ks[10], (DEPTH, GQA_WIDTH, D_MODEL), GQA_WIDTH ** -0.5),
        "gate_bias": nrm(ks[11], (DEPTH, 2 * D_MODEL), 0.02),
        "w_out": nrm(ks[12], (DEPTH, D_MODEL, D_MODEL), D_MODEL ** -0.5),
    }


def reference(x_prompt, x_sample, norm_g, w_in, na_q_g, na_k_g, na_rpb, gq_q_g, gq_k_g,
              w_branch_a, w_branch_b, gate_bias, w_out):
    y_prompt = x_prompt
    y_sample = x_sample
    for l in range(DEPTH):
        y_prompt = encoder_layer(y_prompt, norm_g[l], w_in[l], na_q_g[l], na_k_g[l], na_rpb[l],
                                 gq_q_g[l], gq_k_g[l], w_branch_a[l], w_branch_b[l],
                                 gate_bias[l], w_out[l])
        y_sample = encoder_layer(y_sample, norm_g[l], w_in[l], na_q_g[l], na_k_g[l], na_rpb[l],
                                 gq_q_g[l], gq_k_g[l], w_branch_a[l], w_branch_b[l],
                                 gate_bias[l], w_out[l])
    return (y_prompt, y_sample)
```

```cpp
#include <hip/hip_runtime.h>
#include <cstdio>
#include <cstdint>

constexpr int DM = 2048, MP = 8192, MS = 16384, M = MP + MS;
constexpr int NIN = 10752;
constexpr int C_NAQ = 0, C_NAK = 1024, C_NAV = 2048, C_NAZ = 3072, C_GQQ = 4096, C_GQK = 5120, C_GQV = 5376, C_GQZ = 5632, C_GA = 6656, C_GB = 8704;
constexpr float EPS = 1e-6f;
constexpr float QSCALE = 0.08838834764831845f * 1.4426950408889634f;
constexpr float LOG2E = 1.4426950408889634f;

typedef unsigned short bf16_t;
__device__ __forceinline__ float bf2f(bf16_t b) { return __uint_as_float(((unsigned)b) << 16); }
__device__ __forceinline__ bf16_t f2bf(float f) { unsigned u = __float_as_uint(f); u += 0x7fffu + ((u >> 16) & 1u); return (bf16_t)(u >> 16); }

constexpr size_t MiB = 1u << 20;
constexpr size_t WS_CTL = 0;
constexpr size_t WS_ROPE = 1 * MiB;
constexpr size_t WS_BIAS = 2 * MiB;
constexpr size_t WS_WIN = 4 * MiB, WS_WAB = 46 * MiB, WS_WO = 54 * MiB;
constexpr size_t WS_H = 64 * MiB;
constexpr size_t WS_OAB = WS_H;
constexpr size_t WS_QA = 160 * MiB, WS_KA = 208 * MiB, WS_VA = 256 * MiB, WS_ZA = 304 * MiB;
constexpr size_t WS_QB = 352 * MiB, WS_ZB = 400 * MiB;
constexpr size_t WS_KB = 448 * MiB, WS_VB = 460 * MiB;
constexpr size_t WS_MG = WS_QA;
constexpr size_t WS_END = 472 * MiB;

struct Ptrs {
    const float *xp, *xs, *norm_g, *w_in, *na_q_g, *na_k_g, *na_rpb, *gq_q_g, *gq_k_g, *w_a, *w_b, *gate_bias, *w_out;
    float* out; unsigned char* ws;
};
__device__ __forceinline__ const float* xrow(const Ptrs& P, int m) { return m < MP ? P.xp + (size_t)m * DM : P.xs + (size_t)(m - MP) * DM; }
__device__ __forceinline__ int seq_start(int m) { return m < MP ? 0 : MP + ((m - MP) >> 11 << 11); }
__device__ __forceinline__ int seq_rows(int m) { return m < MP ? 128 : 32; }

__global__ void __launch_bounds__(256) n_rms(Ptrs P) {
    const int m = blockIdx.x * 4 + (threadIdx.x >> 6), lane = threadIdx.x & 63;
    const float* x = xrow(P, m); bf16_t* H = (bf16_t*)(P.ws + WS_H) + (size_t)m * DM;
    float v[32]; float s = 0.f;
#pragma unroll
    for (int i = 0; i < 32; ++i) { v[i] = x[lane + 64 * i]; s += v[i] * v[i]; }
    for (int o = 32; o >= 1; o >>= 1) s += __shfl_xor(s, o);
    const float rstd = 1.0f / sqrtf(s * (1.0f / DM) + EPS);
#pragma unroll
    for (int i = 0; i < 32; ++i) H[lane + 64 * i] = f2bf(v[i] * rstd * P.norm_g[lane + 64 * i]);
}
__global__ void n_rope_tab(Ptrs P) {
    const int i = blockIdx.x * blockDim.x + threadIdx.x; if (i >= 128 * 32) return;
    const int pos = i >> 5, f = i & 31;
    const float freq = powf(10000.0f, -(float)(2 * f) / 64.0f);
    const float ang = (float)pos * freq;
    float* T = (float*)(P.ws + WS_ROPE); T[i] = cosf(ang); T[4096 + i] = sinf(ang);
}
__global__ void __launch_bounds__(256) n_gemm1(Ptrs P) {
    __shared__ float As[16][65]; __shared__ float Bs[16][128]; __shared__ float T[64][129];
    const int tid = threadIdx.x, m0 = blockIdx.x * 64, cg = blockIdx.y, c0 = cg * 128;
    const bf16_t* H = (const bf16_t*)(P.ws + WS_H);
    const int ty = tid >> 4, tx = tid & 15;
    float acc[4][8];
    for (int i = 0; i < 4; ++i) for (int j = 0; j < 8; ++j) acc[i][j] = 0.f;
    for (int k0 = 0; k0 < DM; k0 += 16) {
        for (int i = 0; i < 4; ++i) { const int e = tid + 256 * i, kk = e & 15, r = e >> 4; As[kk][r] = bf2f(H[(size_t)(m0 + r) * DM + k0 + kk]); }
        for (int i = 0; i < 8; ++i) { const int e = tid + 256 * i, n = e & 127, kk = e >> 7; Bs[kk][n] = P.w_in[(size_t)(k0 + kk) * NIN + c0 + n]; }
        __syncthreads();
        for (int kk = 0; kk < 16; ++kk) {
            float a[4], b[8];
            for (int i = 0; i < 4; ++i) a[i] = As[kk][ty * 4 + i];
            for (int j = 0; j < 8; ++j) b[j] = Bs[kk][tx * 8 + j];
            for (int i = 0; i < 4; ++i) for (int j = 0; j < 8; ++j) acc[i][j] += a[i] * b[j];
        }
        __syncthreads();
    }
    for (int i = 0; i < 4; ++i) for (int j = 0; j < 8; ++j) T[ty * 4 + i][tx * 8 + j] = acc[i][j];
    __syncthreads();
    const int row = tid >> 2, part = tid & 3, m = m0 + row;
    float ss = 0.f; for (int j = 0; j < 32; ++j) { const float v = T[row][part * 32 + j]; ss += v * v; }
    ss += __shfl_xor(ss, 1); ss += __shfl_xor(ss, 2);
    const float rstd = 1.0f / sqrtf(ss * (1.0f / 128.0f) + EPS);
    const int pos = m - seq_start(m), gr = pos >> 6, gc = pos & 63;
    const float* RT = (const float*)(P.ws + WS_ROPE);
    unsigned char* ws = P.ws;
    for (int j = 0; j < 32; ++j) {
        const int d = part * 32 + j, c = c0 + d; const float v = T[row][d]; float o; bf16_t* dst;
        if (c < C_NAK) { o = v * rstd * P.na_q_g[d] * QSCALE; dst = (bf16_t*)(ws + WS_QA) + (size_t)m * 1024 + (c - C_NAQ); }
        else if (c < C_NAV) { o = v * rstd * P.na_k_g[d]; dst = (bf16_t*)(ws + WS_KA) + (size_t)m * 1024 + (c - C_NAK); }
        else if (c < C_NAZ) { o = v; dst = (bf16_t*)(ws + WS_VA) + (size_t)m * 1024 + (c - C_NAV); }
        else if (c < C_GQQ) { o = v / (1.0f + expf(-v)); dst = (bf16_t*)(ws + WS_ZA) + (size_t)m * 1024 + (c - C_NAZ); }
        else if (c < C_GQV) {
            const bool isq = c < C_GQK; const float* g = isq ? P.gq_q_g : P.gq_k_g;
            const int sec = d >> 6, i = d & 31, hi = (d >> 5) & 1, p = sec ? gc : gr;
            const float cs = RT[p * 32 + i], sn = RT[4096 + p * 32 + i];
            const int d1 = sec * 64 + i, d2 = d1 + 32;
            const float x1 = T[row][d1] * rstd * g[d1], x2 = T[row][d2] * rstd * g[d2];
            o = hi ? (x2 * cs + x1 * sn) : (x1 * cs - x2 * sn);
            if (isq) { o *= QSCALE; dst = (bf16_t*)(ws + WS_QB) + (size_t)m * 1024 + (c - C_GQQ); }
            else dst = (bf16_t*)(ws + WS_KB) + (size_t)m * 256 + (c - C_GQK);
        }
        else if (c < C_GQZ) { o = v; dst = (bf16_t*)(ws + WS_VB) + (size_t)m * 256 + (c - C_GQV); }
        else if (c < C_GA) { o = v / (1.0f + expf(-v)); dst = (bf16_t*)(ws + WS_ZB) + (size_t)m * 1024 + (c - C_GQZ); }
        else if (c < C_GB) { o = 1.0f / (1.0f + expf(-(v + P.gate_bias[c - C_GA]))); dst = (bf16_t*)P.out + (size_t)m * DM + (c - C_GA); }
        else { o = 1.0f / (1.0f + expf(-(v + P.gate_bias[DM + c - C_GB]))); dst = (bf16_t*)P.out + (size_t)M * DM + (size_t)m * DM + (c - C_GB); }
        *dst = f2bf(o);
    }
}
__global__ void __launch_bounds__(256) n_na(Ptrs P) {
    const int w = blockIdx.x * 4 + (threadIdx.x >> 6), lane = threadIdx.x & 63, m = w >> 3, h = w & 7;
    const bf16_t* QA = (const bf16_t*)(P.ws + WS_QA); const bf16_t* KA = (const bf16_t*)(P.ws + WS_KA); const bf16_t* VA = (const bf16_t*)(P.ws + WS_VA); const bf16_t* ZA = (const bf16_t*)(P.ws + WS_ZA);
    const int s0 = seq_start(m), rows = seq_rows(m), pos = m - s0, r = pos >> 6, c = pos & 63;
    int rs = r - 4; rs = rs < 0 ? 0 : (rs > rows - 8 ? rows - 8 : rs);
    int cs = c - 8; cs = cs < 0 ? 0 : (cs > 48 ? 48 : cs);
    const bf16_t* q = QA + (size_t)m * 1024 + h * 128;
    float sc[2]; int kt[2];
#pragma unroll
    for (int e = 0; e < 2; ++e) {
        const int key = 2 * lane + e, j = key >> 4, kk = key & 15; const int t = s0 + (rs + j) * 64 + cs + kk; kt[e] = t;
        const bf16_t* k = KA + (size_t)t * 1024 + h * 128; float s = 0.f;
        for (int d = 0; d < 128; ++d) s += bf2f(q[d]) * bf2f(k[d]);
        sc[e] = s + P.na_rpb[(h * 15 + (rs + j - r + 7)) * 31 + (cs + kk - c + 15)] * LOG2E;
    }
    float mx = fmaxf(sc[0], sc[1]); for (int o = 32; o >= 1; o >>= 1) mx = fmaxf(mx, __shfl_xor(mx, o));
    float p0 = exp2f(sc[0] - mx), p1 = exp2f(sc[1] - mx), sum = p0 + p1; for (int o = 32; o >= 1; o >>= 1) sum += __shfl_xor(sum, o);
    p0 /= sum; p1 /= sum;
    float o0 = 0.f, o1 = 0.f;
    for (int l = 0; l < 64; ++l) {
        const float a = __shfl(p0, l), b = __shfl(p1, l); const int ta = __shfl(kt[0], l), tb = __shfl(kt[1], l);
        const bf16_t* va = VA + (size_t)ta * 1024 + h * 128 + 2 * lane; const bf16_t* vb = VA + (size_t)tb * 1024 + h * 128 + 2 * lane;
        o0 += a * bf2f(va[0]) + b * bf2f(vb[0]); o1 += a * bf2f(va[1]) + b * bf2f(vb[1]);
    }
    const bf16_t* z = ZA + (size_t)m * 1024 + h * 128 + 2 * lane;
    bf16_t* O = (bf16_t*)(P.ws + WS_OAB) + (size_t)m * DM + h * 128 + 2 * lane;
    O[0] = f2bf(o0 * bf2f(z[0])); O[1] = f2bf(o1 * bf2f(z[1]));
}
__global__ void __launch_bounds__(256) n_gqa(Ptrs P) {
    const int w = blockIdx.x * 4 + (threadIdx.x >> 6), lane = threadIdx.x & 63, m = w >> 3, h = w & 7, kvh = h >> 2;
    const bf16_t* QB = (const bf16_t*)(P.ws + WS_QB); const bf16_t* KB = (const bf16_t*)(P.ws + WS_KB); const bf16_t* VB = (const bf16_t*)(P.ws + WS_VB); const bf16_t* ZB = (const bf16_t*)(P.ws + WS_ZB);
    const int s0 = seq_start(m), L = seq_rows(m) * 64;
    const float q0 = bf2f(QB[(size_t)m * 1024 + h * 128 + 2 * lane]), q1 = bf2f(QB[(size_t)m * 1024 + h * 128 + 2 * lane + 1]);
    float mx = -1e30f, l = 0.f, o0 = 0.f, o1 = 0.f;
    for (int t = 0; t < L; t += 4) {
        float s[4], v0[4], v1[4];
        for (int u = 0; u < 4; ++u) {
            const unsigned kk = *(const unsigned*)(KB + (size_t)(s0 + t + u) * 256 + kvh * 128 + 2 * lane);
            const unsigned vv = *(const unsigned*)(VB + (size_t)(s0 + t + u) * 256 + kvh * 128 + 2 * lane);
            s[u] = q0 * __uint_as_float(kk << 16) + q1 * __uint_as_float(kk & 0xffff0000u);
            v0[u] = __uint_as_float(vv << 16); v1[u] = __uint_as_float(vv & 0xffff0000u);
        }
        for (int o = 32; o >= 1; o >>= 1) for (int u = 0; u < 4; ++u) s[u] += __shfl_xor(s[u], o);
        const float mn = fmaxf(fmaxf(fmaxf(s[0], s[1]), fmaxf(s[2], s[3])), mx);
        const float al = exp2f(mx - mn); mx = mn; l *= al; o0 *= al; o1 *= al;
        for (int u = 0; u < 4; ++u) { const float p = exp2f(s[u] - mn); l += p; o0 += p * v0[u]; o1 += p * v1[u]; }
    }
    const bf16_t* z = ZB + (size_t)m * 1024 + h * 128 + 2 * lane;
    bf16_t* O = (bf16_t*)(P.ws + WS_OAB) + (size_t)m * DM + 1024 + h * 128 + 2 * lane;
    O[0] = f2bf(o0 / l * bf2f(z[0])); O[1] = f2bf(o1 / l * bf2f(z[1]));
}
template <int MODE> __global__ void __launch_bounds__(256) n_gemm2(Ptrs P) {
    __shared__ float As[16][65]; __shared__ float Bs[16][64];
    const int tid = threadIdx.x, m0 = blockIdx.x * 64, n0 = blockIdx.y * 64, ty = tid >> 4, tx = tid & 15;
    const bf16_t* A = (const bf16_t*)(P.ws + (MODE == 0 ? WS_OAB : WS_MG));
    float acc[4][4], res[4][4];
    for (int i = 0; i < 4; ++i) for (int j = 0; j < 4; ++j) { acc[i][j] = 0.f; res[i][j] = 0.f; }
    const bf16_t* GA = (const bf16_t*)P.out; const bf16_t* GB = GA + (size_t)M * DM;
    for (int k0 = 0; k0 < DM; k0 += 16) {
        if (MODE == 0 && k0 == 1024) { for (int i = 0; i < 4; ++i) for (int j = 0; j < 4; ++j) { res[i][j] = acc[i][j] * bf2f(GA[(size_t)(m0 + ty * 4 + i) * DM + n0 + tx * 4 + j]); acc[i][j] = 0.f; } }
        for (int i = 0; i < 4; ++i) { const int e = tid + 256 * i, kk = e & 15, r = e >> 4; As[kk][r] = bf2f(A[(size_t)(m0 + r) * DM + k0 + kk]); }
        for (int i = 0; i < 4; ++i) { const int e = tid + 256 * i, n = e & 63, kk = e >> 6; const int k = k0 + kk;
            Bs[kk][n] = MODE == 0 ? (k < 1024 ? P.w_a[(size_t)k * DM + n0 + n] : P.w_b[(size_t)(k - 1024) * DM + n0 + n]) : P.w_out[(size_t)k * DM + n0 + n]; }
        __syncthreads();
        for (int kk = 0; kk < 16; ++kk) {
            float a[4], b[4];
            for (int i = 0; i < 4; ++i) a[i] = As[kk][ty * 4 + i];
            for (int j = 0; j < 4; ++j) b[j] = Bs[kk][tx * 4 + j];
            for (int i = 0; i < 4; ++i) for (int j = 0; j < 4; ++j) acc[i][j] += a[i] * b[j];
        }
        __syncthreads();
    }
    for (int i = 0; i < 4; ++i) for (int j = 0; j < 4; ++j) {
        const int m = m0 + ty * 4 + i, n = n0 + tx * 4 + j;
        if (MODE == 0) ((bf16_t*)(P.ws + WS_MG))[(size_t)m * DM + n] = f2bf(res[i][j] + acc[i][j] * bf2f(GB[(size_t)m * DM + n]));
        else res[i][j] = xrow(P, m)[n] + acc[i][j];
    }
    if (MODE == 1) {
        for (int i = 0; i < 4; ++i) for (int j = 0; j < 4; ++j) P.out[(size_t)(m0 + ty * 4 + i) * DM + n0 + tx * 4 + j] = res[i][j];
    }
}

extern "C" void kernel_launch(void* const* d_in, const int* in_sizes, int n_in, void* d_out, int out_size, void* d_ws, size_t ws_size, hipStream_t stream) {
    if (n_in != 13 || in_sizes[0] != MP * DM || in_sizes[1] != MS * DM || in_sizes[3] != DM * NIN || out_size != M * DM || ws_size < WS_END) {
        fprintf(stderr, "kernel_launch: shape mismatch n_in %d out %d ws %zu (need %zu)\n", n_in, out_size, ws_size, (size_t)WS_END); return; }
    Ptrs P{};
    P.xp = (const float*)d_in[0]; P.xs = (const float*)d_in[1]; P.norm_g = (const float*)d_in[2]; P.w_in = (const float*)d_in[3];
    P.na_q_g = (const float*)d_in[4]; P.na_k_g = (const float*)d_in[5]; P.na_rpb = (const float*)d_in[6]; P.gq_q_g = (const float*)d_in[7]; P.gq_k_g = (const float*)d_in[8];
    P.w_a = (const float*)d_in[9]; P.w_b = (const float*)d_in[10]; P.gate_bias = (const float*)d_in[11]; P.w_out = (const float*)d_in[12];
    P.out = (float*)d_out; P.ws = (unsigned char*)d_ws;
    hipLaunchKernelGGL(n_rms, dim3(M / 4), dim3(256), 0, stream, P);
    hipLaunchKernelGGL(n_rope_tab, dim3(16), dim3(256), 0, stream, P);
    hipLaunchKernelGGL(n_gemm1, dim3(M / 64, NIN / 128), dim3(256), 0, stream, P);
    hipLaunchKernelGGL(n_na, dim3(M * 8 / 4), dim3(256), 0, stream, P);
    hipLaunchKernelGGL(n_gqa, dim3(M * 8 / 4), dim3(256), 0, stream, P);
    hipLaunchKernelGGL(n_gemm2<0>, dim3(M / 64, DM / 64), dim3(256), 0, stream, P);
    hipLaunchKernelGGL(n_gemm2<1>, dim3(M / 64, DM / 64), dim3(256), 0, stream, P);
}
```

```cpp
#include <hip/hip_runtime.h>
#include <cstdio>
#include <cstdint>

constexpr int DM = 2048, MP = 8192, MS = 16384, M = MP + MS;
constexpr int NIN = 10752;
constexpr int C_NAQ = 0, C_NAK = 1024, C_NAV = 2048, C_NAZ = 3072, C_GQQ = 4096, C_GQK = 5120, C_GQV = 5376, C_GQZ = 5632, C_GA = 6656, C_GB = 8704;
constexpr float EPS = 1e-6f;
constexpr float QSCALE = 0.08838834764831845f * 1.4426950408889634f;
constexpr float LOG2E = 1.4426950408889634f;

typedef unsigned short bf16_t;
__device__ __forceinline__ float bf2f(bf16_t b) { return __uint_as_float(((unsigned)b) << 16); }
__device__ __forceinline__ bf16_t f2bf(float f) { unsigned u = __float_as_uint(f); u += 0x7fffu + ((u >> 16) & 1u); return (bf16_t)(u >> 16); }

constexpr size_t MiB = 1u << 20;
constexpr size_t WS_CTL = 0;
constexpr size_t WS_ROPE = 1 * MiB;
constexpr size_t WS_BIAS = 2 * MiB;
constexpr size_t WS_WIN = 4 * MiB, WS_WAB = 46 * MiB, WS_WO = 54 * MiB;
constexpr size_t WS_H = 64 * MiB;
constexpr size_t WS_OAB = WS_H;
constexpr size_t WS_QA = 160 * MiB, WS_KA = 208 * MiB, WS_VA = 256 * MiB, WS_ZA = 304 * MiB;
constexpr size_t WS_QB = 352 * MiB, WS_ZB = 400 * MiB;
constexpr size_t WS_KB = 448 * MiB, WS_VB = 460 * MiB;
constexpr size_t WS_MG = WS_QA;
constexpr size_t WS_END = 472 * MiB;

struct Ptrs {
    const float *xp, *xs, *norm_g, *w_in, *na_q_g, *na_k_g, *na_rpb, *gq_q_g, *gq_k_g, *w_a, *w_b, *gate_bias, *w_out;
    float* out; unsigned char* ws;
};
__device__ __forceinline__ const float* xrow(const Ptrs& P, int m) { return m < MP ? P.xp + (size_t)m * DM : P.xs + (size_t)(m - MP) * DM; }
__device__ __forceinline__ int seq_start(int m) { return m < MP ? 0 : MP + ((m - MP) >> 11 << 11); }
__device__ __forceinline__ int seq_rows(int m) { return m < MP ? 128 : 32; }

__global__ void __launch_bounds__(256) n_rms(Ptrs P) {
    const int m = blockIdx.x * 4 + (threadIdx.x >> 6), lane = threadIdx.x & 63;
    const float* x = xrow(P, m); bf16_t* H = (bf16_t*)(P.ws + WS_H) + (size_t)m * DM;
    float v[32]; float s = 0.f;
#pragma unroll
    for (int i = 0; i < 32; ++i) { v[i] = x[lane + 64 * i]; s += v[i] * v[i]; }
    for (int o = 32; o >= 1; o >>= 1) s += __shfl_xor(s, o);
    const float rstd = 1.0f / sqrtf(s * (1.0f / DM) + EPS);
#pragma unroll
    for (int i = 0; i < 32; ++i) H[lane + 64 * i] = f2bf(v[i] * rstd * P.norm_g[lane + 64 * i]);
}
__global__ void n_rope_tab(Ptrs P) {
    const int i = blockIdx.x * blockDim.x + threadIdx.x; if (i >= 128 * 32) return;
    const int pos = i >> 5, f = i & 31;
    const float freq = powf(10000.0f, -(float)(2 * f) / 64.0f);
    const float ang = (float)pos * freq;
    float* T = (float*)(P.ws + WS_ROPE); T[i] = cosf(ang); T[4096 + i] = sinf(ang);
}
__global__ void __launch_bounds__(256) n_gemm1(Ptrs P) {
    __shared__ float As[16][65]; __shared__ float Bs[16][128]; __shared__ float T[64][129];
    const int tid = threadIdx.x, m0 = blockIdx.x * 64, cg = blockIdx.y, c0 = cg * 128;
    const bf16_t* H = (const bf16_t*)(P.ws + WS_H);
    const int ty = tid >> 4, tx = tid & 15;
    float acc[4][8];
    for (int i = 0; i < 4; ++i) for (int j = 0; j < 8; ++j) acc[i][j] = 0.f;
    for (int k0 = 0; k0 < DM; k0 += 16) {
        for (int i = 0; i < 4; ++i) { const int e = tid + 256 * i, kk = e & 15, r = e >> 4; As[kk][r] = bf2f(H[(size_t)(m0 + r) * DM + k0 + kk]); }
        for (int i = 0; i < 8; ++i) { const int e = tid + 256 * i, n = e & 127, kk = e >> 7; Bs[kk][n] = P.w_in[(size_t)(k0 + kk) * NIN + c0 + n]; }
        __syncthreads();
        for (int kk = 0; kk < 16; ++kk) {
            float a[4], b[8];
            for (int i = 0; i < 4; ++i) a[i] = As[kk][ty * 4 + i];
            for (int j = 0; j < 8; ++j) b[j] = Bs[kk][tx * 8 + j];
            for (int i = 0; i < 4; ++i) for (int j = 0; j < 8; ++j) acc[i][j] += a[i] * b[j];
        }
        __syncthreads();
    }
    for (int i = 0; i < 4; ++i) for (int j = 0; j < 8; ++j) T[ty * 4 + i][tx * 8 + j] = acc[i][j];
    __syncthreads();
    const int row = tid >> 2, part = tid & 3, m = m0 + row;
    float ss = 0.f; for (int j = 0; j < 32; ++j) { const float v = T[row][part * 32 + j]; ss += v * v; }
    ss += __shfl_xor(ss, 1); ss += __shfl_xor(ss, 2);
    const float rstd = 1.0f / sqrtf(ss * (1.0f / 128.0f) + EPS);
    const int pos = m - seq_start(m), gr = pos >> 6, gc = pos & 63;
    const float* RT = (const float*)(P.ws + WS_ROPE);
    unsigned char* ws = P.ws;
    for (int j = 0; j < 32; ++j) {
        const int d = part * 32 + j, c = c0 + d; const float v = T[row][d]; float o; bf16_t* dst;
        if (c < C_NAK) { o = v * rstd * P.na_q_g[d] * QSCALE; dst = (bf16_t*)(ws + WS_QA) + (size_t)m * 1024 + (c - C_NAQ); }
        else if (c < C_NAV) { o = v * rstd * P.na_k_g[d]; dst = (bf16_t*)(ws + WS_KA) + (size_t)m * 1024 + (c - C_NAK); }
        else if (c < C_NAZ) { o = v; dst = (bf16_t*)(ws + WS_VA) + (size_t)m * 1024 + (c - C_NAV); }
        else if (c < C_GQQ) { o = v / (1.0f + expf(-v)); dst = (bf16_t*)(ws + WS_ZA) + (size_t)m * 1024 + (c - C_NAZ); }
        else if (c < C_GQV) {
            const bool isq = c < C_GQK; const float* g = isq ? P.gq_q_g : P.gq_k_g;
            const int sec = d >> 6, i = d & 31, hi = (d >> 5) & 1, p = sec ? gc : gr;
            const float cs = RT[p * 32 + i], sn = RT[4096 + p * 32 + i];
            const int d1 = sec * 64 + i, d2 = d1 + 32;
            const float x1 = T[row][d1] * rstd * g[d1], x2 = T[row][d2] * rstd * g[d2];
            o = hi ? (x2 * cs + x1 * sn) : (x1 * cs - x2 * sn);
            if (isq) { o *= QSCALE; dst = (bf16_t*)(ws + WS_QB) + (size_t)m * 1024 + (c - C_GQQ); }
            else dst = (bf16_t*)(ws + WS_KB) + (size_t)m * 256 + (c - C_GQK);
        }
        else if (c < C_GQZ) { o = v; dst = (bf16_t*)(ws + WS_VB) + (size_t)m * 256 + (c - C_GQV); }
        else if (c < C_GA) { o = v / (1.0f + expf(-v)); dst = (bf16_t*)(ws + WS_ZB) + (size_t)m * 1024 + (c - C_GQZ); }
        else if (c < C_GB) { o = 1.0f / (1.0f + expf(-(v + P.gate_bias[c - C_GA]))); dst = (bf16_t*)P.out + (size_t)m * DM + (c - C_GA); }
        else { o = 1.0f / (1.0f + expf(-(v + P.gate_bias[DM + c - C_GB]))); dst = (bf16_t*)P.out + (size_t)M * DM + (size_t)m * DM + (c - C_GB); }
        *dst = f2bf(o);
    }
}
__global__ void __launch_bounds__(256) n_na(Ptrs P) {
    const int w = blockIdx.x * 4 + (threadIdx.x >> 6), lane = threadIdx.x & 63, m = w >> 3, h = w & 7;
    const bf16_t* QA = (const bf16_t*)(P.ws + WS_QA); const bf16_t* KA = (const bf16_t*)(P.ws + WS_KA); const bf16_t* VA = (const bf16_t*)(P.ws + WS_VA); const bf16_t* ZA = (const bf16_t*)(P.ws + WS_ZA);
    const int s0 = seq_start(m), rows = seq_rows(m), pos = m - s0, r = pos >> 6, c = pos & 63;
    int rs = r - 4; rs = rs < 0 ? 0 : (rs > rows - 8 ? rows - 8 : rs);
    int cs = c - 8; cs = cs < 0 ? 0 : (cs > 48 ? 48 : cs);
    const bf16_t* q = QA + (size_t)m * 1024 + h * 128;
    float sc[2]; int kt[2];
#pragma unroll
    for (int e = 0; e < 2; ++e) {
        const int key = 2 * lane + e, j = key >> 4, kk = key & 15; const int t = s0 + (rs + j) * 64 + cs + kk; kt[e] = t;
        const bf16_t* k = KA + (size_t)t * 1024 + h * 128; float s = 0.f;
        for (int d = 0; d < 128; ++d) s += bf2f(q[d]) * bf2f(k[d]);
        sc[e] = s + P.na_rpb[(h * 15 + (rs + j - r + 7)) * 31 + (cs + kk - c + 15)] * LOG2E;
    }
    float mx = fmaxf(sc[0], sc[1]); for (int o = 32; o >= 1; o >>= 1) mx = fmaxf(mx, __shfl_xor(mx, o));
    float p0 = exp2f(sc[0] - mx), p1 = exp2f(sc[1] - mx), sum = p0 + p1; for (int o = 32; o >= 1; o >>= 1) sum += __shfl_xor(sum, o);
    p0 /= sum; p1 /= sum;
    float o0 = 0.f, o1 = 0.f;
    for (int l = 0; l < 64; ++l) {
        const float a = __shfl(p0, l), b = __shfl(p1, l); const int ta = __shfl(kt[0], l), tb = __shfl(kt[1], l);
        const bf16_t* va = VA + (size_t)ta * 1024 + h * 128 + 2 * lane; const bf16_t* vb = VA + (size_t)tb * 1024 + h * 128 + 2 * lane;
        o0 += a * bf2f(va[0]) + b * bf2f(vb[0]); o1 += a * bf2f(va[1]) + b * bf2f(vb[1]);
    }
    const bf16_t* z = ZA + (size_t)m * 1024 + h * 128 + 2 * lane;
    bf16_t* O = (bf16_t*)(P.ws + WS_OAB) + (size_t)m * DM + h * 128 + 2 * lane;
    O[0] = f2bf(o0 * bf2f(z[0])); O[1] = f2bf(o1 * bf2f(z[1]));
}
__global__ void __launch_bounds__(256) n_gqa(Ptrs P) {
    const int w = blockIdx.x * 4 + (threadIdx.x >> 6), lane = threadIdx.x & 63, m = w >> 3, h = w & 7, kvh = h >> 2;
    const bf16_t* QB = (const bf16_t*)(P.ws + WS_QB); const bf16_t* KB = (const bf16_t*)(P.ws + WS_KB); const bf16_t* VB = (const bf16_t*)(P.ws + WS_VB); const bf16_t* ZB = (const bf16_t*)(P.ws + WS_ZB);
    const int s0 = seq_start(m), L = seq_rows(m) * 64;
    const float q0 = bf2f(QB[(size_t)m * 1024 + h * 128 + 2 * lane]), q1 = bf2f(QB[(size_t)m * 1024 + h * 128 + 2 * lane + 1]);
    float mx = -1e30f, l = 0.f, o0 = 0.f, o1 = 0.f;
    for (int t = 0; t < L; t += 4) {
        float s[4], v0[4], v1[4];
        for (int u = 0; u < 4; ++u) {
            const unsigned kk = *(const unsigned*)(KB + (size_t)(s0 + t + u) * 256 + kvh * 128 + 2 * lane);
            const unsigned vv = *(const unsigned*)(VB + (size_t)(s0 + t + u) * 256 + kvh * 128 + 2 * lane);
            s[u] = q0 * __uint_as_float(kk << 16) + q1 * __uint_as_float(kk & 0xffff0000u);
            v0[u] = __uint_as_float(vv << 16); v1[u] = __uint_as_float(vv & 0xffff0000u);
        }
        for (int o = 32; o >= 1; o >>= 1) for (int u = 0; u < 4; ++u) s[u] += __shfl_xor(s[u], o);
        const float mn = fmaxf(fmaxf(fmaxf(s[0], s[1]), fmaxf(s[2], s[3])), mx);
        const float al = exp2f(mx - mn); mx = mn; l *= al; o0 *= al; o1 *= al;
        for (int u = 0; u < 4; ++u) { const float p = exp2f(s[u] - mn); l += p; o0 += p * v0[u]; o1 += p * v1[u]; }
    }
    const bf16_t* z = ZB + (size_t)m * 1024 + h * 128 + 2 * lane;
    bf16_t* O = (bf16_t*)(P.ws + WS_OAB) + (size_t)m * DM + 1024 + h * 128 + 2 * lane;
    O[0] = f2bf(o0 / l * bf2f(z[0])); O[1] = f2bf(o1 / l * bf2f(z[1]));
}
template <int MODE> __global__ void __launch_bounds__(256) n_gemm2(Ptrs P) {
    __shared__ float As[16][65]; __shared__ float Bs[16][64];
    const int tid = threadIdx.x, m0 = blockIdx.x * 64, n0 = blockIdx.y * 64, ty = tid >> 4, tx = tid & 15;
    const bf16_t* A = (const bf16_t*)(P.ws + (MODE == 0 ? WS_OAB : WS_MG));
    float acc[4][4], res[4][4];
    for (int i = 0; i < 4; ++i) for (int j = 0; j < 4; ++j) { acc[i][j] = 0.f; res[i][j] = 0.f; }
    const bf16_t* GA = (const bf16_t*)P.out; const bf16_t* GB = GA + (size_t)M * DM;
    for (int k0 = 0; k0 < DM; k0 += 16) {
        if (MODE == 0 && k0 == 1024) { for (int i = 0; i < 4; ++i) for (int j = 0; j < 4; ++j) { res[i][j] = acc[i][j] * bf2f(GA[(size_t)(m0 + ty * 4 + i) * DM + n0 + tx * 4 + j]); acc[i][j] = 0.f; } }
        for (int i = 0; i < 4; ++i) { const int e = tid + 256 * i, kk = e & 15, r = e >> 4; As[kk][r] = bf2f(A[(size_t)(m0 + r) * DM + k0 + kk]); }
        for (int i = 0; i < 4; ++i) { const int e = tid + 256 * i, n = e & 63, kk = e >> 6; const int k = k0 + kk;
            Bs[kk][n] = MODE == 0 ? (k < 1024 ? P.w_a[(size_t)k * DM + n0 + n] : P.w_b[(size_t)(k - 1024) * DM + n0 + n]) : P.w_out[(size_t)k * DM + n0 + n]; }
        __syncthreads();
        for (int kk = 0; kk < 16; ++kk) {
            float a[4], b[4];
            for (int i = 0; i < 4; ++i) a[i] = As[kk][ty * 4 + i];
            for (int j = 0; j < 4; ++j) b[j] = Bs[kk][tx * 4 + j];
            for (int i = 0; i < 4; ++i) for (int j = 0; j < 4; ++j) acc[i][j] += a[i] * b[j];
        }
        __syncthreads();
    }
    for (int i = 0; i < 4; ++i) for (int j = 0; j < 4; ++j) {
        const int m = m0 + ty * 4 + i, n = n0 + tx * 4 + j;
        if (MODE == 0) ((bf16_t*)(P.ws + WS_MG))[(size_t)m * DM + n] = f2bf(res[i][j] + acc[i][j] * bf2f(GB[(size_t)m * DM + n]));
        else res[i][j] = xrow(P, m)[n] + acc[i][j];
    }
    if (MODE == 1) {
        for (int i = 0; i < 4; ++i) for (int j = 0; j < 4; ++j) P.out[(size_t)(m0 + ty * 4 + i) * DM + n0 + tx * 4 + j] = res[i][j];
    }
}

namespace pg8 {
#define PG8_LAS __attribute__((address_space(3)))
typedef short bf16x8 __attribute__((ext_vector_type(8)));
typedef float f32x4 __attribute__((ext_vector_type(4)));
typedef unsigned u32x4 __attribute__((ext_vector_type(4)));
typedef unsigned u32x2 __attribute__((ext_vector_type(2)));
constexpr int BM = 256, BK = 64, HALF = 128, HTB = HALF * BK * 2, STAGE_BYTES = 8 * HTB, NXCD = 8, WGM = 8;

__host__ __device__ __forceinline__ int lds_byte(int r, int c) { const int st = (r >> 4) * 2 + (c >> 5), rr = r & 15, cc = c & 31, ob = rr * 64 + cc * 2; return st * 1024 + (ob ^ (((ob >> 9) & 1) << 5)); }
__host__ __device__ __forceinline__ void stage_rc(int b, int& R, int& C) { const int st = b / 1024, sb = b % 1024, swz = sb ^ (((sb >> 9) & 1) << 5); R = (st >> 1) * 16 + swz / 64; C = (st & 1) * 32 + (swz % 64) / 2; }

struct Unit { int pm, pn; };
struct Gemm { const bf16_t* A; const bf16_t* Bt; int M, N, K; };

struct StaticOrder {
    int nM, nN, nwg, G, c;
    __host__ __device__ void init(int M_, int N_, int G_, int c_) { nM = M_ / BM; nN = N_ / BM; nwg = nM * nN; G = G_; c = c_; }
    __host__ __device__ bool next(int i, Unit& u) const {
        const long L = (long)i * G + c; if (L >= nwg) return false;
        int wgid = (int)L; { const int q = nwg / NXCD, r = nwg % NXCD, xcd = wgid % NXCD, off = wgid / NXCD; wgid = (xcd < r ? xcd * (q + 1) : r * (q + 1) + (xcd - r) * q) + off; }
        const int nig = WGM * nN, gid = wgid / nig, fm = gid * WGM, gsz = (nM - fm) < WGM ? (nM - fm) : WGM;
        u.pm = fm + ((wgid % nig) % gsz); u.pn = (wgid % nig) / gsz; return true;
    }
    __device__ __forceinline__ void a_ready(const Unit&) const {}
    __device__ __forceinline__ void done(const Unit&) const {}
};

__device__ __forceinline__ unsigned cvt_pk_bf16(float lo, float hi) { unsigned r; asm volatile("v_cvt_pk_bf16_f32 %0, %1, %2" : "=v"(r) : "v"(lo), "v"(hi)); return r; }
__device__ __forceinline__ float bflo(unsigned w) { return __uint_as_float(w << 16); }
__device__ __forceinline__ float bfhi(unsigned w) { return __uint_as_float(w & 0xffff0000u); }
__device__ __forceinline__ float sigm(float v) { return __builtin_amdgcn_rcpf(1.0f + __builtin_amdgcn_exp2f(-v * LOG2E)); }

enum { T_PLAIN = 0, T_SILU = 1, T_GATE = 2, T_NORM = 3, T_ROPE = 4 };
struct EpiA {
    static constexpr bool PERM = false, AFTER_DRAIN = false, HAS_MID = false;
    Ptrs P; PG8_LAS float* X;
    __device__ __forceinline__ void mid(f32x4 (&)[2][2][4][2], const Unit&, int, int, int, int) const {}
    __device__ __forceinline__ void operator()(f32x4 (&acc)[2][2][4][2], const Unit& u, int wr, int wc, int fr, int fq) const {
        const int pn = u.pn; unsigned char* ws = P.ws;
        int type, ldc = 1024, coff; bf16_t* dst; const float* gw = P.na_q_g; float gs = 1.f; const float* bias = P.gate_bias;
        if (pn < 4)        { type = T_NORM;  dst = (bf16_t*)(ws + WS_QA); coff = pn * 256; gw = P.na_q_g; gs = QSCALE; }
        else if (pn < 8)   { type = T_NORM;  dst = (bf16_t*)(ws + WS_KA); coff = (pn - 4) * 256; gw = P.na_k_g; }
        else if (pn < 12)  { type = T_PLAIN; dst = (bf16_t*)(ws + WS_VA); coff = (pn - 8) * 256; }
        else if (pn < 16)  { type = T_SILU;  dst = (bf16_t*)(ws + WS_ZA); coff = (pn - 12) * 256; }
        else if (pn < 20)  { type = T_ROPE;  dst = (bf16_t*)(ws + WS_QB); coff = (pn - 16) * 256; gw = P.gq_q_g; gs = QSCALE; }
        else if (pn == 20) { type = T_ROPE;  dst = (bf16_t*)(ws + WS_KB); coff = 0; ldc = 256; gw = P.gq_k_g; }
        else if (pn == 21) { type = T_PLAIN; dst = (bf16_t*)(ws + WS_VB); coff = 0; ldc = 256; }
        else if (pn < 26)  { type = T_SILU;  dst = (bf16_t*)(ws + WS_ZB); coff = (pn - 22) * 256; }
        else if (pn < 34)  { type = T_GATE;  dst = (bf16_t*)P.out; coff = (pn - 26) * 256; ldc = 2048; bias = P.gate_bias + coff; }
        else               { type = T_GATE;  dst = (bf16_t*)P.out + (size_t)M * DM; coff = (pn - 34) * 256; ldc = 2048; bias = P.gate_bias + 2048 + coff; }
        const int row0 = u.pm * BM + wr * 64 + fr, c8 = wc * 32 + 8 * fq;
        if (type <= T_GATE) {
            f32x4 bv[2][2];
#pragma unroll
            for (int bj = 0; bj < 2; ++bj)
#pragma unroll
                for (int n = 0; n < 2; ++n) bv[bj][n] = (type == T_GATE) ? *(const f32x4*)(bias + bj * HALF + c8 + 4 * n) : (f32x4){0.f, 0.f, 0.f, 0.f};
#pragma unroll
            for (int ai = 0; ai < 2; ++ai)
#pragma unroll
                for (int m = 0; m < 4; ++m) { bf16_t* rowp = dst + (size_t)(row0 + ai * HALF + m * 16) * ldc + coff + c8;
#pragma unroll
                    for (int bj = 0; bj < 2; ++bj) { f32x4 v0 = acc[ai][bj][m][0] + bv[bj][0], v1 = acc[ai][bj][m][1] + bv[bj][1];
                        if (type == T_SILU) {
#pragma unroll
                            for (int j = 0; j < 4; ++j) { v0[j] = v0[j] * sigm(v0[j]); v1[j] = v1[j] * sigm(v1[j]); } }
                        if (type == T_GATE) {
#pragma unroll
                            for (int j = 0; j < 4; ++j) { v0[j] = sigm(v0[j]); v1[j] = sigm(v1[j]); } }
                        u32x4 w; w.x = cvt_pk_bf16(v0[0], v0[1]); w.y = cvt_pk_bf16(v0[2], v0[3]); w.z = cvt_pk_bf16(v1[0], v1[1]); w.w = cvt_pk_bf16(v1[2], v1[3]);
                        *(u32x4*)(rowp + bj * HALF) = w; } }
        } else {
            const int trow = wr * 64 + fr;
#pragma unroll
            for (int ai = 0; ai < 2; ++ai)
#pragma unroll
                for (int m = 0; m < 4; ++m)
#pragma unroll
                    for (int bj = 0; bj < 2; ++bj) { const f32x4 a = acc[ai][bj][m][0], b = acc[ai][bj][m][1];
                        float s = (a[0] * a[0] + a[1] * a[1]) + (a[2] * a[2] + a[3] * a[3]) + (b[0] * b[0] + b[1] * b[1]) + (b[2] * b[2] + b[3] * b[3]);
                        s += __shfl_xor(s, 16); s += __shfl_xor(s, 32);
                        if (fq == 0) X[(ai * HALF + m * 16 + trow) * 8 + bj * 4 + wc] = s; }
            asm volatile("s_waitcnt lgkmcnt(0)" ::: "memory"); __builtin_amdgcn_s_barrier(); asm volatile("" ::: "memory");
            if (type == T_NORM) {
                f32x4 g0 = *(const f32x4*)(gw + c8) * gs, g1 = *(const f32x4*)(gw + c8 + 4) * gs;
#pragma unroll
                for (int ai = 0; ai < 2; ++ai)
#pragma unroll
                    for (int m = 0; m < 4; ++m) { bf16_t* rowp = dst + (size_t)(row0 + ai * HALF + m * 16) * ldc + coff + c8;
#pragma unroll
                        for (int bj = 0; bj < 2; ++bj) { const f32x4 t = *(const PG8_LAS f32x4*)(X + (ai * HALF + m * 16 + trow) * 8 + bj * 4);
                            const float rstd = __builtin_amdgcn_rsqf(((t[0] + t[1]) + (t[2] + t[3])) * (1.0f / 128.0f) + EPS);
                            const f32x4 v0 = acc[ai][bj][m][0] * g0 * rstd, v1 = acc[ai][bj][m][1] * g1 * rstd;
                            u32x4 w; w.x = cvt_pk_bf16(v0[0], v0[1]); w.y = cvt_pk_bf16(v0[2], v0[3]); w.z = cvt_pk_bf16(v1[0], v1[1]); w.w = cvt_pk_bf16(v1[2], v1[3]);
                            *(u32x4*)(rowp + bj * HALF) = w; } }
            } else {
                const int sec = wc >> 1, i0 = 16 * (wc & 1) + 4 * fq, d0 = 64 * sec + i0;
                const f32x4 g1 = *(const f32x4*)(gw + d0) * gs, g2 = *(const f32x4*)(gw + d0 + 32) * gs;
                const int t0 = u.pm * BM, s0 = t0 < MP ? 0 : MP + (((t0 - MP) >> 11) << 11), gr0 = ((t0 - s0) >> 6) + wr;
                const float* RT = (const float*)(ws + WS_ROPE);
#pragma unroll
                for (int ai = 0; ai < 2; ++ai)
#pragma unroll
                    for (int m = 0; m < 4; ++m) { bf16_t* rowp = dst + (size_t)(row0 + ai * HALF + m * 16) * ldc + coff + d0;
                        const int p = sec ? (m * 16 + fr) : (gr0 + 2 * ai);
                        const f32x4 cs = *(const f32x4*)(RT + p * 32 + i0), sn = *(const f32x4*)(RT + 4096 + p * 32 + i0);
#pragma unroll
                        for (int bj = 0; bj < 2; ++bj) { const f32x4 t = *(const PG8_LAS f32x4*)(X + (ai * HALF + m * 16 + trow) * 8 + bj * 4);
                            const float rstd = __builtin_amdgcn_rsqf(((t[0] + t[1]) + (t[2] + t[3])) * (1.0f / 128.0f) + EPS);
                            const f32x4 x1 = acc[ai][bj][m][0] * g1 * rstd, x2 = acc[ai][bj][m][1] * g2 * rstd;
                            const f32x4 y1 = x1 * cs - x2 * sn, y2 = x2 * cs + x1 * sn;
                            u32x2 w1, w2; w1.x = cvt_pk_bf16(y1[0], y1[1]); w1.y = cvt_pk_bf16(y1[2], y1[3]); w2.x = cvt_pk_bf16(y2[0], y2[1]); w2.y = cvt_pk_bf16(y2[2], y2[3]);
                            *(u32x2*)(rowp + bj * HALF) = w1; *(u32x2*)(rowp + bj * HALF + 32) = w2; } }
            }
        }
    }
};
struct EpiC1 {
    static constexpr bool PERM = false, AFTER_DRAIN = false, HAS_MID = true;
    const bf16_t* GA; const bf16_t* GB; bf16_t* MG;
    __device__ __forceinline__ void mid(f32x4 (&acc)[2][2][4][2], const Unit& u, int wr, int wc, int fr, int fq) const {
        asm volatile("" : "+v"(fr), "+v"(fq));
        const size_t off0 = (size_t)(u.pm * BM + wr * 64 + fr) * DM + u.pn * BM + wc * 32 + 8 * fq;
#pragma unroll
        for (int ai = 0; ai < 2; ++ai)
#pragma unroll
            for (int m = 0; m < 4; ++m)
#pragma unroll
                for (int bj = 0; bj < 2; ++bj) { const size_t off = off0 + (size_t)(ai * HALF + m * 16) * DM + bj * HALF;
                    const u32x4 a = *(const u32x4*)(GA + off), b = *(const u32x4*)(GB + off);
                    f32x4 r0, r1;
                    r0[0] = bflo(a.x) * __builtin_amdgcn_rcpf(bflo(b.x)); r0[1] = bfhi(a.x) * __builtin_amdgcn_rcpf(bfhi(b.x));
                    r0[2] = bflo(a.y) * __builtin_amdgcn_rcpf(bflo(b.y)); r0[3] = bfhi(a.y) * __builtin_amdgcn_rcpf(bfhi(b.y));
                    r1[0] = bflo(a.z) * __builtin_amdgcn_rcpf(bflo(b.z)); r1[1] = bfhi(a.z) * __builtin_amdgcn_rcpf(bfhi(b.z));
                    r1[2] = bflo(a.w) * __builtin_amdgcn_rcpf(bflo(b.w)); r1[3] = bfhi(a.w) * __builtin_amdgcn_rcpf(bfhi(b.w));
                    acc[ai][bj][m][0] = acc[ai][bj][m][0] * r0; acc[ai][bj][m][1] = acc[ai][bj][m][1] * r1; asm volatile("" ::: "memory"); }
    }
    __device__ __forceinline__ void operator()(f32x4 (&acc)[2][2][4][2], const Unit& u, int wr, int wc, int fr, int fq) const {
        asm volatile("" : "+v"(fr), "+v"(fq));
        const size_t off0 = (size_t)(u.pm * BM + wr * 64 + fr) * DM + u.pn * BM + wc * 32 + 8 * fq;
#pragma unroll
        for (int ai = 0; ai < 2; ++ai)
#pragma unroll
            for (int m = 0; m < 4; ++m)
#pragma unroll
                for (int bj = 0; bj < 2; ++bj) { const size_t off = off0 + (size_t)(ai * HALF + m * 16) * DM + bj * HALF;
                    const u32x4 b = *(const u32x4*)(GB + off);
                    const f32x4 v0 = acc[ai][bj][m][0] * (f32x4){bflo(b.x), bfhi(b.x), bflo(b.y), bfhi(b.y)}, v1 = acc[ai][bj][m][1] * (f32x4){bflo(b.z), bfhi(b.z), bflo(b.w), bfhi(b.w)};
                    u32x4 w; w.x = cvt_pk_bf16(v0[0], v0[1]); w.y = cvt_pk_bf16(v0[2], v0[3]); w.z = cvt_pk_bf16(v1[0], v1[1]); w.w = cvt_pk_bf16(v1[2], v1[3]);
                    *(u32x4*)(MG + off) = w; asm volatile("" ::: "memory"); }
    }
};
struct EpiC2 {
    static constexpr bool PERM = false, AFTER_DRAIN = false, HAS_MID = false;
    const float* xp; const float* xs; float* out;
    __device__ __forceinline__ void mid(f32x4 (&)[2][2][4][2], const Unit&, int, int, int, int) const {}
    __device__ __forceinline__ void operator()(f32x4 (&acc)[2][2][4][2], const Unit& u, int wr, int wc, int fr, int fq) const {
        const int col0 = u.pn * BM + wc * 32 + 4 * fq;
#pragma unroll
        for (int ai = 0; ai < 2; ++ai)
#pragma unroll
            for (int m = 0; m < 4; ++m) { const int grow = u.pm * BM + ai * HALF + wr * 64 + m * 16 + fr;
                const float* xr = (grow < MP ? xp + (size_t)grow * DM : xs + (size_t)(grow - MP) * DM) + col0; float* orow = out + (size_t)grow * DM + col0;
#pragma unroll
                for (int bj = 0; bj < 2; ++bj)
#pragma unroll
                    for (int n = 0; n < 2; ++n) *(f32x4*)(orow + bj * HALF + n * 16) = *(const f32x4*)(xr + bj * HALF + n * 16) + acc[ai][bj][m][n];
                asm volatile("" ::: "memory"); }
    }
};

template <class Epi, class Sched, bool ALIGN_EPI = false, bool SP2 = false>
__device__ __forceinline__ void gemm_phase(PG8_LAS unsigned char* lds, const Gemm g, const Sched& S, const Epi& E) {
    const int tid = threadIdx.x, wid = __builtin_amdgcn_readfirstlane(tid >> 6), lane = tid & 63, wr = wid >> 2, wc = wid & 3, fr = lane & 15, fq = lane >> 4;
    const int K = g.K, nt = K / BK;
    unsigned voffA[2];
#pragma unroll
    for (int i = 0; i < 2; ++i) { int R, C; stage_rc(tid * 16 + i * 8192, R, C); voffA[i] = (unsigned)(R * K + C) * 2u; }
#define voffB voffA
    const size_t kstep = (size_t)(BK * 2);
    const size_t hstep = (size_t)HALF * K * 2;
    const size_t tstep = 2 * hstep;
    const unsigned ldsw = (unsigned)wid * 1024u;
    const int aoff = lds_byte(wr * 64 + fr, fq * 8), boff = lds_byte(wc * 32 + fr, fq * 8);
#define PG8_SA(b, h) (((b) * 2 + (h)) * HTB)
#define PG8_SB(b, h) ((4 + (b) * 2 + (h)) * HTB)
#define PG8_STAGE(bufoff, gbase, voff) do { _Pragma("unroll") for (int _i = 0; _i < 2; ++_i) \
        __builtin_amdgcn_global_load_lds((const unsigned*)((const char*)(gbase) + (voff)[_i]), (PG8_LAS unsigned*)(lds + (bufoff) + ldsw + _i * 8192), 16, 0, 0); } while (0)
#define PG8_LDA(dst, b, h) do { _Pragma("unroll") for (int m = 0; m < 4; ++m) _Pragma("unroll") for (int k = 0; k < 2; ++k) dst[m][k] = *(const PG8_LAS bf16x8*)(lds + PG8_SA(b, h) + aoff + m * 2048 + k * 1024); } while (0)
#define PG8_LDB(dst, b, h) do { _Pragma("unroll") for (int n = 0; n < 2; ++n) _Pragma("unroll") for (int k = 0; k < 2; ++k) dst[n][k] = *(const PG8_LAS bf16x8*)(lds + PG8_SB(b, h) + boff + n * 2048 + k * 1024); } while (0)
#define PG8_MMA(ai, bj, At, Bt) do { __builtin_amdgcn_s_setprio(1); _Pragma("unroll") for (int m = 0; m < 4; ++m) _Pragma("unroll") for (int n = 0; n < 2; ++n) _Pragma("unroll") for (int k = 0; k < 2; ++k) \
        acc[ai][bj][m][n] = __builtin_amdgcn_mfma_f32_16x16x32_bf16(Bt[n][k], At[m][k], acc[ai][bj][m][n], 0, 0, 0); __builtin_amdgcn_s_setprio(0); } while (0)
#define PG8_WAIT_V(n) asm volatile("s_waitcnt vmcnt(" #n ")" ::: "memory")
#define PG8_WAIT_L(n) asm volatile("s_waitcnt lgkmcnt(" #n ")" ::: "memory")
#define PG8_BAR __builtin_amdgcn_s_barrier()
#define PG8_SCHED __builtin_amdgcn_sched_barrier(0)
    Unit cur, nxt; int ui = 0;
    if (!S.next(0, cur)) return;
    f32x4 acc[2][2][4][2];
#pragma unroll
    for (int a = 0; a < 2; ++a)
#pragma unroll
        for (int b = 0; b < 2; ++b)
#pragma unroll
            for (int m = 0; m < 4; ++m)
#pragma unroll
                for (int n = 0; n < 2; ++n) acc[a][b][m][n] = (f32x4){0.f, 0.f, 0.f, 0.f};
    bf16x8 At[4][2], B0[2][2], B1[2][2];
    const char* cA = (const char*)g.A + (size_t)cur.pm * tstep; const char* cB = (const char*)g.Bt + (size_t)cur.pn * tstep;
    S.a_ready(cur);
    if constexpr (SP2) {
        PG8_STAGE(PG8_SB(0, 0), cB, voffB); PG8_STAGE(PG8_SB(0, 1), cB + hstep, voffB); PG8_STAGE(PG8_SA(0, 0), cA, voffA); PG8_STAGE(PG8_SA(0, 1), cA + hstep, voffA);
        if (wr == 1) PG8_BAR;
        PG8_WAIT_V(2); PG8_BAR;
        PG8_STAGE(PG8_SB(1, 0), cB + kstep, voffB); PG8_STAGE(PG8_SA(1, 0), cA + kstep, voffA); PG8_STAGE(PG8_SB(1, 1), cB + hstep + kstep, voffB);
        PG8_WAIT_V(6); PG8_BAR;
    } else {
        PG8_STAGE(PG8_SB(0, 0), cB, voffB); PG8_STAGE(PG8_SA(0, 0), cA, voffA); PG8_STAGE(PG8_SB(0, 1), cB + hstep, voffB); PG8_STAGE(PG8_SA(0, 1), cA + hstep, voffA);
        if (wr == 1) PG8_BAR;
        PG8_WAIT_V(4); PG8_BAR;
        PG8_STAGE(PG8_SB(1, 0), cB + kstep, voffB); PG8_STAGE(PG8_SA(1, 0), cA + kstep, voffA); PG8_STAGE(PG8_SB(1, 1), cB + hstep + kstep, voffB);
        PG8_WAIT_V(6); PG8_BAR;
    }
    for (;;) {
        const bool has_next = S.next(ui + 1, nxt);
        const char* nA = has_next ? (const char*)g.A + (size_t)nxt.pm * tstep : cA; const char* nB = has_next ? (const char*)g.Bt + (size_t)nxt.pn * tstep : cB;
        for (int t = 0; t < nt; t += 2) {
            const bool last = (t == nt - 2);
            const char* a1 = cA + (size_t)(t + 1) * kstep;
            const char* a2 = last ? nA : cA + (size_t)(t + 2) * kstep; const char* b2 = last ? nB : cB + (size_t)(t + 2) * kstep;
            const char* a3 = a2 + kstep; const char* b3 = b2 + kstep;
            if (last && has_next) S.a_ready(nxt);
            if constexpr (Epi::HAS_MID) { if (t == nt / 2) E.mid(acc, cur, wr, wc, fr, fq); }
            if constexpr (SP2) {
            PG8_LDB(B0, 0, 0); PG8_LDB(B1, 0, 1); PG8_SCHED; PG8_LDA(At, 0, 0); PG8_STAGE(PG8_SA(1, 1), a1 + hstep, voffA);
            PG8_WAIT_V(8); PG8_WAIT_L(0); PG8_BAR; PG8_MMA(0, 0, At, B0); PG8_MMA(0, 1, At, B1); PG8_BAR; PG8_SCHED;
            PG8_LDA(At, 0, 1); PG8_STAGE(PG8_SB(0, 0), b2, voffB); PG8_STAGE(PG8_SB(0, 1), b2 + hstep, voffB); PG8_STAGE(PG8_SA(0, 0), a2, voffA);
            PG8_WAIT_V(8); PG8_WAIT_L(0); PG8_BAR; PG8_MMA(1, 0, At, B0); PG8_MMA(1, 1, At, B1); PG8_BAR; PG8_SCHED;
            PG8_LDB(B0, 1, 0); PG8_LDB(B1, 1, 1); PG8_SCHED; PG8_LDA(At, 1, 0); PG8_STAGE(PG8_SA(0, 1), a2 + hstep, voffA);
            PG8_WAIT_V(8); PG8_WAIT_L(0); PG8_BAR; PG8_MMA(0, 0, At, B0); PG8_MMA(0, 1, At, B1); PG8_BAR; PG8_SCHED;
            PG8_LDA(At, 1, 1); PG8_STAGE(PG8_SB(1, 0), b3, voffB); PG8_STAGE(PG8_SB(1, 1), b3 + hstep, voffB); PG8_STAGE(PG8_SA(1, 0), a3, voffA);
            PG8_WAIT_V(8); PG8_WAIT_L(0); PG8_BAR; PG8_MMA(1, 0, At, B0); PG8_MMA(1, 1, At, B1); PG8_BAR; PG8_SCHED;
            } else {
            PG8_LDB(B0, 0, 0); PG8_SCHED; PG8_LDA(At, 0, 0); PG8_STAGE(PG8_SA(1, 1), a1 + hstep, voffA);
            PG8_WAIT_L(8); PG8_BAR; PG8_WAIT_L(0); PG8_MMA(0, 0, At, B0); PG8_BAR; PG8_SCHED;
            PG8_LDB(B1, 0, 1); PG8_STAGE(PG8_SB(0, 0), b2, voffB);
            PG8_BAR; PG8_WAIT_L(0); PG8_MMA(0, 1, At, B1); PG8_BAR;
            PG8_LDA(At, 0, 1); PG8_STAGE(PG8_SA(0, 0), a2, voffA);
            PG8_BAR; PG8_WAIT_L(0); PG8_MMA(1, 0, At, B0); PG8_BAR; PG8_SCHED;
            PG8_STAGE(PG8_SB(0, 1), b2 + hstep, voffB);
            PG8_WAIT_V(6); PG8_BAR; PG8_MMA(1, 1, At, B1); PG8_BAR;
            PG8_LDB(B0, 1, 0); PG8_SCHED; PG8_LDA(At, 1, 0); PG8_STAGE(PG8_SA(0, 1), a2 + hstep, voffA);
            PG8_WAIT_L(8); PG8_BAR; PG8_WAIT_L(0); PG8_MMA(0, 0, At, B0); PG8_BAR; PG8_SCHED;
            PG8_LDB(B1, 1, 1); PG8_STAGE(PG8_SB(1, 0), b3, voffB);
            PG8_BAR; PG8_WAIT_L(0); PG8_MMA(0, 1, At, B1); PG8_BAR;
            PG8_LDA(At, 1, 1); PG8_STAGE(PG8_SA(1, 0), a3, voffA);
            PG8_BAR; PG8_WAIT_L(0); PG8_MMA(1, 0, At, B0); PG8_BAR; PG8_SCHED;
            PG8_STAGE(PG8_SB(1, 1), b3 + hstep, voffB);
            PG8_WAIT_V(6); PG8_BAR; PG8_MMA(1, 1, At, B1); PG8_BAR;
            }
        }
        if constexpr (ALIGN_EPI) { if (wr == 0) PG8_BAR; }
        E(acc, cur, wr, wc, fr, fq); S.done(cur);
        if (!has_next) break;
#pragma unroll
        for (int a = 0; a < 2; ++a)
#pragma unroll
            for (int b = 0; b < 2; ++b)
#pragma unroll
                for (int m = 0; m < 4; ++m)
#pragma unroll
                    for (int n = 0; n < 2; ++n) acc[a][b][m][n] = (f32x4){0.f, 0.f, 0.f, 0.f};
        cur = nxt; cA = nA; cB = nB; ++ui;
        if constexpr (ALIGN_EPI) { if (wr == 1) PG8_BAR; }
    }
    PG8_WAIT_V(0);
    if constexpr (!ALIGN_EPI) { if (wr == 0) PG8_BAR; }
    PG8_BAR;
#undef voffB
#undef PG8_SA
#undef PG8_SB
#undef PG8_STAGE
#undef PG8_LDA
#undef PG8_LDB
#undef PG8_MMA
#undef PG8_WAIT_V
#undef PG8_WAIT_L
#undef PG8_BAR
#undef PG8_SCHED
}
}

namespace att {
using bf16x8 = __attribute__((ext_vector_type(8))) short;
using s16x4  = __attribute__((ext_vector_type(4))) short;
using f32x16 = __attribute__((ext_vector_type(16))) float;
using f32x4  = __attribute__((ext_vector_type(4))) float;
using u32x4  = __attribute__((ext_vector_type(4))) unsigned;
constexpr int D = 128, NW = 8, QBLK = 32, KVBLK = 64;
constexpr float THRL = 8.f * LOG2E;
constexpr int LDQ = 1024, LDKB = 256, LDO = 2048;
constexpr size_t SHM_V = KVBLK * D * 2, SHM_K = KVBLK * D * 2, SHM_ATTN = 2 * SHM_V + 2 * SHM_K + NW * 64 * 4;
#define KSWZ(row, colB) ((row) * 256 + ((colB) ^ (((row) & 7) << 4)))
#define SBAR() __builtin_amdgcn_sched_barrier(0)
__device__ __forceinline__ int crow(int r, int hi) { return (r & 3) + 8 * (r >> 2) + 4 * hi; }
__device__ __forceinline__ unsigned cvtpk(float lo, float hi) { unsigned r; asm volatile("v_cvt_pk_bf16_f32 %0, %1, %2" : "=v"(r) : "v"(lo), "v"(hi)); return r; }
__device__ __forceinline__ bf16x8 ld8(const bf16_t* p) { return *reinterpret_cast<const bf16x8*>(p); }

__device__ __forceinline__ void partialSM(f32x16& p0, f32x16& p1, float& m_reg, float& mn, float& alpha) {
  float pmax = p0[0]; for (int r = 1; r < 16; ++r) pmax = fmaxf(pmax, p0[r]); for (int r = 0; r < 16; ++r) pmax = fmaxf(pmax, p1[r]);
  { auto rr = __builtin_amdgcn_permlane32_swap(__float_as_uint(pmax), __float_as_uint(pmax), false, false);
    pmax = fmaxf(__uint_as_float(rr[0]), __uint_as_float(rr[1])); }
  if (__builtin_expect(__all(pmax - m_reg <= THRL), 1)) { mn = m_reg; alpha = 1.f; }
  else { mn = fmaxf(m_reg, pmax); alpha = __builtin_amdgcn_exp2f(m_reg - mn); m_reg = mn; }
  for (int r = 0; r < 16; ++r) p0[r] = p0[r] - mn; for (int r = 0; r < 16; ++r) p1[r] = p1[r] - mn;
  for (int r = 0; r < 16; ++r) p0[r] = __builtin_amdgcn_exp2f(p0[r]);
}
#define PK4(P, BASE, OUT) do { unsigned a0 = cvtpk(P[BASE + 0], P[BASE + 1]), a1 = cvtpk(P[BASE + 2], P[BASE + 3]);   \
    unsigned b0 = cvtpk(P[BASE + 4], P[BASE + 5]), b1 = cvtpk(P[BASE + 6], P[BASE + 7]);                              \
    auto r0 = __builtin_amdgcn_permlane32_swap(a0, b0, false, false); auto r1 = __builtin_amdgcn_permlane32_swap(a1, b1, false, false); \
    u32x4 w = {r0[0], r1[0], r0[1], r1[1]}; OUT = *reinterpret_cast<bf16x8*>(&w); } while (0)
__device__ __forceinline__ void finishSM(f32x16& p0, f32x16& p1, float alpha, float& l_reg, bf16x8& pa0, bf16x8& pa1, bf16x8& pa2, bf16x8& pa3) {
  for (int r = 0; r < 16; ++r) p1[r] = __builtin_amdgcn_exp2f(p1[r]);
  float ps = 0; for (int r = 0; r < 16; ++r) ps += p0[r]; for (int r = 0; r < 16; ++r) ps += p1[r];
  { auto rr = __builtin_amdgcn_permlane32_swap(__float_as_uint(ps), __float_as_uint(ps), false, false);
    ps = __uint_as_float(rr[0]) + __uint_as_float(rr[1]); }
  l_reg = l_reg * alpha + ps;
  PK4(p0, 0, pa0); PK4(p0, 8, pa1); PK4(p1, 0, pa2); PK4(p1, 8, pa3);
}
__device__ __forceinline__ void qkt_acc(f32x16& p0, f32x16& p1, const char* Ks, const bf16x8* qr, int r32, int hi) {
  for (int d0 = 0; d0 < 8; ++d0) { int cb = (d0 * 16 + hi * 8) * 2;
    bf16x8 b0 = *reinterpret_cast<const bf16x8*>(Ks + KSWZ(r32, cb));
    bf16x8 b1 = *reinterpret_cast<const bf16x8*>(Ks + KSWZ(32 + r32, cb));
    p0 = __builtin_amdgcn_mfma_f32_32x32x16_bf16(b0, qr[d0], p0, 0, 0, 0);
    p1 = __builtin_amdgcn_mfma_f32_32x32x16_bf16(b1, qr[d0], p1, 0, 0, 0); }
}
__device__ __forceinline__ int v_st(int k, int c) { const int kk = (k & ~0xC) | ((k & 4) << 1) | ((k & 8) >> 1); return ((kk >> 3) * 4 + (c >> 5)) * 512 + ((kk & 7) * 32 + (c & 31)) * 2; }
__device__ __forceinline__ int v_rd_base(int lane) { return ((lane & 3) << 3) | (((lane >> 2) & 3) << 6) | (((lane >> 4) & 1) << 5) | (((lane >> 5) & 1) << 8); }
constexpr int v_rd_off(int d0, int ks, int half) { return d0 * 512 + ks * 4096 + half * 2048; }
template <int OFF> __device__ __forceinline__ s16x4 tr_read(int vb) {
  s16x4 r; asm volatile("ds_read_b64_tr_b16 %0, %1 offset:%2" : "=&v"(r) : "v"(vb), "i"(OFF) : "memory"); return r;
}
template <int D0> __device__ __forceinline__ void pv_one(f32x16& od, int vb, bf16x8 pa0, bf16x8 pa1, bf16x8 pa2, bf16x8 pa3) {
  const s16x4 l0 = tr_read<v_rd_off(D0, 0, 0)>(vb), h0 = tr_read<v_rd_off(D0, 0, 1)>(vb), l1 = tr_read<v_rd_off(D0, 1, 0)>(vb), h1 = tr_read<v_rd_off(D0, 1, 1)>(vb);
  const s16x4 l2 = tr_read<v_rd_off(D0, 2, 0)>(vb), h2 = tr_read<v_rd_off(D0, 2, 1)>(vb), l3 = tr_read<v_rd_off(D0, 3, 0)>(vb), h3 = tr_read<v_rd_off(D0, 3, 1)>(vb);
  asm volatile("s_waitcnt lgkmcnt(0)" ::: "memory"); SBAR();
#define PK(L, H) (bf16x8){L[0], L[1], L[2], L[3], H[0], H[1], H[2], H[3]}
  od = __builtin_amdgcn_mfma_f32_32x32x16_bf16(pa0, PK(l0, h0), od, 0, 0, 0);
  od = __builtin_amdgcn_mfma_f32_32x32x16_bf16(pa1, PK(l1, h1), od, 0, 0, 0);
  od = __builtin_amdgcn_mfma_f32_32x32x16_bf16(pa2, PK(l2, h2), od, 0, 0, 0);
  od = __builtin_amdgcn_mfma_f32_32x32x16_bf16(pa3, PK(l3, h3), od, 0, 0, 0);
#undef PK
}
__device__ __forceinline__ void pv_d0(f32x16* o, int vb, bf16x8 pa0, bf16x8 pa1, bf16x8 pa2, bf16x8 pa3) {
  pv_one<0>(o[0], vb, pa0, pa1, pa2, pa3); pv_one<1>(o[1], vb, pa0, pa1, pa2, pa3); pv_one<2>(o[2], vb, pa0, pa1, pa2, pa3); pv_one<3>(o[3], vb, pa0, pa1, pa2, pa3);
}
__device__ __forceinline__ void store_o(const f32x16* o, float l_full, const bf16_t* __restrict__ Zw, bf16_t* __restrict__ Ow, float* li_l, int r32, int hi) {
  asm volatile("" : "+v"(r32), "+v"(hi));
  if (hi == 0) li_l[r32] = l_full; asm volatile("s_waitcnt lgkmcnt(0)" ::: "memory");
  float rli[16];
#pragma unroll
  for (int r = 0; r < 16; ++r) rli[r] = __builtin_amdgcn_rcpf(li_l[crow(r, hi)]);
#pragma unroll
  for (int r = 0; r < 16; ++r) { const int orow = crow(r, hi);
#pragma unroll
    for (int d0 = 0; d0 < 4; ++d0) { const float z = bf2f(Zw[(size_t)orow * LDQ + d0 * 32 + r32]); Ow[(size_t)orow * LDO + d0 * 32 + r32] = f2bf(o[d0][r] * rli[r] * z); }
    asm volatile("" ::: "memory"); }
}

__device__ __forceinline__ void gqa_unit(const bf16_t* __restrict__ Qb, const bf16_t* __restrict__ Kh, const bf16_t* __restrict__ Vh, const bf16_t* __restrict__ Zb, bf16_t* __restrict__ Ob, int seq, char* lds) {
  const int tid = threadIdx.x, wid = tid >> 6, lane = tid & 63, r32 = lane & 31, hi = lane >> 5;
  char* V_lds = lds; char* K_lds = lds + 2 * SHM_V;
  float* wsc = (float*)(lds + 2 * SHM_V + 2 * SHM_K) + wid * 64; float* li_l = wsc; float* al_l = wsc + 32;
  float m_reg = -1e30f, l_reg = 0; f32x16 o[4] = {}; bf16x8 qr[8];
  const bf16_t* Qw = Qb + (size_t)(wid * QBLK + r32) * LDQ + hi * 8;
#pragma unroll
  for (int d0 = 0; d0 < 8; ++d0) qr[d0] = ld8(Qw + d0 * 16);
  const int sr = tid >> 4, sc = (tid & 15) * 8, vst0 = v_st(sr, sc), vst1 = v_st(32 + sr, sc);
  const int vb0 = (int)(uintptr_t)V_lds + v_rd_base(lane);
  struct { bf16x8 vs0, vs1, ks0, ks1; } sr_[2];
#define SLOAD(i, k0) do { sr_[i].vs0 = ld8(&Vh[(size_t)((k0) + sr) * LDKB + sc]); sr_[i].vs1 = ld8(&Vh[(size_t)((k0) + 32 + sr) * LDKB + sc]); \
    sr_[i].ks0 = ld8(&Kh[(size_t)((k0) + sr) * LDKB + sc]); sr_[i].ks1 = ld8(&Kh[(size_t)((k0) + 32 + sr) * LDKB + sc]); } while (0)
#define SWRITE(b, i) do { *(bf16x8*)(V_lds + (b) * SHM_V + vst0) = sr_[i].vs0;          \
    *(bf16x8*)(V_lds + (b) * SHM_V + vst1) = sr_[i].vs1; int kc = sc * 2;               \
    *(bf16x8*)(K_lds + (b) * SHM_K + KSWZ(sr, kc)) = sr_[i].ks0;                       \
    *(bf16x8*)(K_lds + (b) * SHM_K + KSWZ(32 + sr, kc)) = sr_[i].ks1; } while (0)
#define SWAIT() asm volatile("s_waitcnt vmcnt(4)" ::: "memory")
#define RESC(a) do { if (__any((a) < 1.f)) { if (hi == 0) al_l[r32] = (a); asm volatile("s_waitcnt lgkmcnt(0)" ::: "memory"); \
    for (int d = 0; d < 4; ++d) for (int r = 0; r < 16; ++r) o[d][r] *= al_l[crow(r, hi)]; } } while (0)
  f32x16 pA0, pA1, pB0, pB1; float mnA, mnB, alA, alB; bf16x8 pa0, pa1, pa2, pa3; const int NT = seq / KVBLK;
  constexpr int SE = 0, SO = 1;
  SLOAD(SE, 0); asm volatile("s_waitcnt vmcnt(0)" ::: "memory"); SWRITE(0, SE); __syncthreads();
  pA0 = f32x16{}; pA1 = f32x16{}; qkt_acc(pA0, pA1, K_lds, qr, r32, hi); partialSM(pA0, pA1, m_reg, mnA, alA);
  SLOAD(SO, KVBLK); if (2 < NT) SLOAD(SE, 2 * KVBLK);
  SWAIT(); SWRITE(1, SO); __syncthreads();
  for (int j = 1; j + 1 < NT; j += 2) {
    SBAR(); pB0 = f32x16{}; pB1 = f32x16{}; qkt_acc(pB0, pB1, K_lds + SHM_K, qr, r32, hi);
    finishSM(pA0, pA1, alA, l_reg, pa0, pa1, pa2, pa3); SBAR();
    SLOAD(SO, (j + 2) * KVBLK); SBAR();
    pv_d0(o, vb0, pa0, pa1, pa2, pa3); partialSM(pB0, pB1, m_reg, mnB, alB);
    __syncthreads(); SWAIT(); SWRITE(0, SE);
    RESC(alB); __syncthreads();
    SBAR(); pA0 = f32x16{}; pA1 = f32x16{}; qkt_acc(pA0, pA1, K_lds, qr, r32, hi);
    finishSM(pB0, pB1, alB, l_reg, pa0, pa1, pa2, pa3); SBAR();
    if (j + 3 < NT) SLOAD(SE, (j + 3) * KVBLK); SBAR();
    pv_d0(o, vb0 + (int)SHM_V, pa0, pa1, pa2, pa3); partialSM(pA0, pA1, m_reg, mnA, alA);
    __syncthreads(); SWAIT(); SWRITE(1, SO);
    RESC(alA); __syncthreads();
  }
  SBAR(); pB0 = f32x16{}; pB1 = f32x16{}; qkt_acc(pB0, pB1, K_lds + SHM_K, qr, r32, hi);
  finishSM(pA0, pA1, alA, l_reg, pa0, pa1, pa2, pa3); SBAR();
  pv_d0(o, vb0, pa0, pa1, pa2, pa3); partialSM(pB0, pB1, m_reg, mnB, alB);
  __syncthreads(); RESC(alB);
  finishSM(pB0, pB1, alB, l_reg, pa0, pa1, pa2, pa3); SBAR();
  pv_d0(o, vb0 + (int)SHM_V, pa0, pa1, pa2, pa3);
  store_o(o, l_reg, Zb + (size_t)(wid * QBLK) * LDQ, Ob + (size_t)(wid * QBLK) * LDO, li_l, r32, hi);
#undef SLOAD
#undef SWRITE
#undef SWAIT
#undef RESC
}

__device__ __forceinline__ int clampi(int v, int lo, int hi) { return v < lo ? lo : (v > hi ? hi : v); }
__device__ __forceinline__ void na_unit(const bf16_t* __restrict__ Q, const bf16_t* __restrict__ K, const bf16_t* __restrict__ V, const bf16_t* __restrict__ Z, bf16_t* __restrict__ O,
                                        const float* __restrict__ BT, int m0, int s0, int R, int h, char* lds) {
  const int tid = threadIdx.x, wid = __builtin_amdgcn_readfirstlane(tid >> 6), lane = tid & 63, r32 = lane & 31, hi = lane >> 5;
  char* V_lds = lds; char* K_lds = lds + 2 * SHM_V;
  float* li_l = (float*)(lds + 2 * SHM_V + 2 * SHM_K) + wid * 64;
  const int r0 = (m0 - s0) >> 6, r = r0 + (wid >> 1), half = wid & 1;
  const int rs = clampi(r - 4, 0, R - 8), lo = clampi(r0 - 4, 0, R - 8), NT = clampi(r0 - 1, 0, R - 8) + 8 - lo;
  bf16x8 qr[8];
  const bf16_t* Qw = Q + (size_t)(m0 + wid * QBLK + r32) * LDQ + h * D + hi * 8;
#pragma unroll
  for (int d0 = 0; d0 < 8; ++d0) qr[d0] = ld8(Qw + d0 * 16);
  const int sr = tid >> 4, sc = (tid & 15) * 8, vst0 = v_st(sr, sc), vst1 = v_st(32 + sr, sc);
  const int vb0 = (int)(uintptr_t)V_lds + v_rd_base(lane);
  const bf16_t* Kt = K + (size_t)(s0 + 64 * lo + sr) * LDQ + h * D + sc; const bf16_t* Vt = V + (size_t)(s0 + 64 * lo + sr) * LDQ + h * D + sc;
  bf16x8 vs0, vs1, ks0, ks1;
#define NLOAD(j) do { vs0 = ld8(Vt + (size_t)(j) * 65536); vs1 = ld8(Vt + (size_t)(j) * 65536 + 32 * LDQ); ks0 = ld8(Kt + (size_t)(j) * 65536); ks1 = ld8(Kt + (size_t)(j) * 65536 + 32 * LDQ); } while (0)
#define NWRITE(b) do { *(bf16x8*)(V_lds + (b) * SHM_V + vst0) = vs0; *(bf16x8*)(V_lds + (b) * SHM_V + vst1) = vs1; int kc = sc * 2; \
    *(bf16x8*)(K_lds + (b) * SHM_K + KSWZ(sr, kc)) = ks0; *(bf16x8*)(K_lds + (b) * SHM_K + KSWZ(32 + sr, kc)) = ks1; } while (0)
  f32x16 o[4] = {}; float l = 0.f;
  __syncthreads();
  NLOAD(0); NWRITE(0);
  for (int j = 0; j < NT; ++j) {
    if (j + 1 < NT) NLOAD(j + 1);
    __syncthreads();
    const int kr = lo + j;
    if (kr >= rs && kr < rs + 8) {
      const float* bt = BT + ((size_t)(((h * 15 + (kr - r + 7)) * 2 + half) * 8) * 64 + lane) * 4;
      f32x16 p0, p1;
#pragma unroll
      for (int i = 0; i < 4; ++i) { const f32x4 t = *(const f32x4*)(bt + i * 256); p0[4 * i] = t[0]; p0[4 * i + 1] = t[1]; p0[4 * i + 2] = t[2]; p0[4 * i + 3] = t[3]; }
#pragma unroll
      for (int i = 0; i < 4; ++i) { const f32x4 t = *(const f32x4*)(bt + (4 + i) * 256); p1[4 * i] = t[0]; p1[4 * i + 1] = t[1]; p1[4 * i + 2] = t[2]; p1[4 * i + 3] = t[3]; }
      qkt_acc(p0, p1, K_lds + (j & 1) * SHM_K, qr, r32, hi);
#pragma unroll
      for (int q = 0; q < 16; ++q) { p0[q] = __builtin_amdgcn_exp2f(p0[q]); p1[q] = __builtin_amdgcn_exp2f(p1[q]); }
      float ps = 0.f;
#pragma unroll
      for (int q = 0; q < 16; ++q) ps += p0[q] + p1[q];
      l += ps;
      bf16x8 pa0, pa1, pa2, pa3;
      PK4(p0, 0, pa0); PK4(p0, 8, pa1); PK4(p1, 0, pa2); PK4(p1, 8, pa3);
      pv_d0(o, vb0 + (j & 1) * (int)SHM_V, pa0, pa1, pa2, pa3);
    }
    if (j + 1 < NT) NWRITE((j + 1) & 1);
  }
  { auto rr = __builtin_amdgcn_permlane32_swap(__float_as_uint(l), __float_as_uint(l), false, false); l = __uint_as_float(rr[0]) + __uint_as_float(rr[1]); }
  store_o(o, l, Z + (size_t)(m0 + wid * QBLK) * LDQ + h * D, O + (size_t)(m0 + wid * QBLK) * LDO + h * D, li_l, r32, hi);
#undef NLOAD
#undef NWRITE
}
#undef PK4
#undef SBAR
}

constexpr int NWAVES = 8;
constexpr int RING_OFF = 0, RING_BYTES = 131072;
constexpr int XCH_OFF = RING_BYTES, XCH_BYTES = 8192;
constexpr int LDSCTL_OFF = XCH_OFF + XCH_BYTES, MISC_OFF = LDSCTL_OFF + 320;
constexpr int LDS_BYTES = 147456;
static_assert(MISC_OFF + 128 <= LDS_BYTES, "LDS map");
constexpr size_t CTL_ZERO_BYTES = 256 * 1024;
constexpr int CW_BAR = 4096;

#define GAS __attribute__((address_space(1)))
#define LAS __attribute__((address_space(3)))
typedef unsigned v4u __attribute__((ext_vector_type(4)));
typedef float f32x4 __attribute__((ext_vector_type(4)));
typedef GAS unsigned gu32;
#define LDS_WAIT() asm volatile("s_waitcnt lgkmcnt(0)" ::: "memory")
#define VM_WAIT() asm volatile("s_waitcnt vmcnt(0)" ::: "memory")
__device__ __forceinline__ unsigned pk2(float lo, float hi) { return (unsigned)f2bf(lo) | ((unsigned)f2bf(hi) << 16); }

#define XB_TMO      128
#define XB_XCNT(j)  (256  + 64 * (j))
#define XB_XSUB(j)  (1280 + 64 * (j))
#define XB_XGEN(j)  (2304 + 64 * (j))
#define XB_TOP      3328
#define XB_TOPGEN   3392
#define XCD_BAR_WORDS 3456
#define XB_SPIN_CAP (1u << 22)
__device__ __forceinline__ unsigned xb_ld(unsigned* p)              { return __hip_atomic_load(p, __ATOMIC_RELAXED, __HIP_MEMORY_SCOPE_AGENT); }
__device__ __forceinline__ unsigned xb_add(unsigned* p, unsigned v) { return __hip_atomic_fetch_add(p, v, __ATOMIC_RELAXED, __HIP_MEMORY_SCOPE_AGENT); }
__device__ __forceinline__ unsigned xb_xcc_id() { return (unsigned)__builtin_amdgcn_s_getreg((3 << 11) | 20) & 0xFu; }
#define XB_SPIN(cond, bar) do { unsigned _sp = 0; while (cond) { __builtin_amdgcn_s_sleep(1); \
    if ((++_sp & 255u) == 0u) { if (xb_ld(&(bar)[XB_TMO])) break; if (_sp > XB_SPIN_CAP) { atomicAdd(&(bar)[XB_TMO], 1u); break; } } } } while (0)
struct XcdBarrier { unsigned* bar; unsigned x; volatile LAS unsigned* st; };
__device__ __forceinline__ XcdBarrier xcd_barrier_post(unsigned* bar, volatile LAS unsigned* st) {
    XcdBarrier b; b.bar = bar; b.x = xb_xcc_id(); b.st = st;
    if (threadIdx.x == 0) (void)xb_add(&bar[XB_XCNT(b.x)], 1u);
    return b;
}
__device__ __forceinline__ void xcd_barrier_complete(unsigned* bar, unsigned x, unsigned& nloc, unsigned& nx) {
    const unsigned G = gridDim.x * gridDim.y * gridDim.z;
    unsigned sum, cnt, mine, sp = 0u;
    for (;;) {
        sum = 0u; cnt = 0u; mine = 0u;
#pragma unroll
        for (unsigned j = 0; j < 16; ++j) { const unsigned c = xb_ld(&bar[XB_XCNT(j)]); sum += c; cnt += (c > 0u) ? 1u : 0u; mine = (j == x) ? c : mine; }
        if (sum == G) break;
        __builtin_amdgcn_s_sleep(1);
        if ((++sp & 255u) == 0u) { if (xb_ld(&bar[XB_TMO])) break; if (sp > XB_SPIN_CAP) { atomicAdd(&bar[XB_TMO], 1u); break; } }
    }
    nloc = mine > 0u ? mine : 1u; nx = cnt > 0u ? cnt : 1u;
}
__device__ __forceinline__ void xcd_barrier(const XcdBarrier& b) {
    asm volatile("s_waitcnt vmcnt(0)" ::: "memory");
    __syncthreads();
    if (threadIdx.x == 0) {
        unsigned* bar = b.bar;
        __builtin_amdgcn_s_waitcnt(0);
        unsigned nloc = b.st[0], nx = b.st[1];
        if (nloc == 0u) { xcd_barrier_complete(bar, b.x, nloc, nx); b.st[0] = nloc; b.st[1] = nx; }
        const unsigned old = xb_add(&bar[XB_XSUB(b.x)], 1u);
        const unsigned gen = old / nloc;
        if (old + 1u == (gen + 1u) * nloc) {
            __builtin_amdgcn_fence(__ATOMIC_RELEASE, "agent");
            asm volatile("s_waitcnt vmcnt(0)" ::: "memory");
            const unsigned og = xb_add(&bar[XB_TOP], 1u);
            const unsigned tg = og / nx;
            if (og + 1u == (tg + 1u) * nx) xb_add(&bar[XB_TOPGEN], 1u);
            else XB_SPIN(xb_ld(&bar[XB_TOPGEN]) == tg, bar);
            __builtin_amdgcn_fence(__ATOMIC_ACQUIRE, "agent");
            xb_add(&bar[XB_XGEN(b.x)], 1u);
            asm volatile("s_waitcnt vmcnt(0)" ::: "memory");
        } else {
            XB_SPIN(xb_ld(&bar[XB_XGEN(b.x)]) == gen, bar);
            __builtin_amdgcn_fence(__ATOMIC_ACQUIRE, "agent");
            asm volatile("s_waitcnt vmcnt(0)" ::: "memory");
        }
    }
    __syncthreads();
}

__device__ __forceinline__ float wave_sum(float v) {
#pragma unroll
    for (int o = 1; o < 64; o <<= 1) v += __shfl_xor(v, o);
    return v;
}
__device__ __forceinline__ float wave_max(float v) {
#pragma unroll
    for (int o = 1; o < 64; o <<= 1) v = fmaxf(v, __shfl_xor(v, o));
    return v;
}
__device__ __forceinline__ int rowmap(int kind, int n) {
    if (kind == 1) { const int cc = n & 31; return (n & ~31) + 16 * ((cc >> 2) & 1) + 4 * (cc >> 3) + (cc & 3); }
    if (kind == 2) { const int d = n & 127; return (n & ~127) + 32 * (2 * (d >> 6) + ((d >> 4) & 1)) + 16 * ((d >> 5) & 1) + 4 * ((d >> 2) & 3) + (d & 3); }
    return n;
}
__device__ __forceinline__ void p0_transpose_item(const float* W, int N, bf16_t* WT, int ldk, int koff, int kind, LAS float* scr, int item, int lane) {
    const int nblk = N / 32, kb = item / nblk, nb = item % nblk, k0 = 64 * kb, n0 = 32 * nb;
#pragma unroll 8
    for (int i = 0; i < 32; ++i) { const int kk = 2 * i + (lane >> 5); scr[kk * 33 + (lane & 31)] = W[(size_t)(k0 + kk) * N + n0 + (lane & 31)]; }
    LDS_WAIT(); asm volatile("" ::: "memory");
    const int c = lane & 7;
#pragma unroll
    for (int j = 0; j < 4; ++j) { const int n = (lane >> 3) + 8 * j; const LAS float* s = scr + (8 * c) * 33 + n;
        v4u o; o.x = pk2(s[0 * 33], s[1 * 33]); o.y = pk2(s[2 * 33], s[3 * 33]); o.z = pk2(s[4 * 33], s[5 * 33]); o.w = pk2(s[6 * 33], s[7 * 33]);
        *(GAS v4u*)(WT + (size_t)rowmap(kind, n0 + n) * ldk + koff + k0 + 8 * c) = o; }
    LDS_WAIT(); asm volatile("" ::: "memory");
}
__device__ __forceinline__ void rms_row_to_bf16(const float* xr_, const float* g_, bf16_t* orow, int lane) {
    const GAS f32x4* xr = (const GAS f32x4*)xr_ + lane; const GAS f32x4* gr = (const GAS f32x4*)g_ + lane;
    f32x4 v[8]; float s = 0.f;
#pragma unroll
    for (int j = 0; j < 8; ++j) { v[j] = xr[64 * j]; s += (v[j].x * v[j].x + v[j].y * v[j].y) + (v[j].z * v[j].z + v[j].w * v[j].w); }
    const float rstd = 1.0f / sqrtf(wave_sum(s) * (1.f / DM) + EPS);
    GAS unsigned long long* o8 = (GAS unsigned long long*)orow + lane;
#pragma unroll
    for (int j = 0; j < 8; ++j) { const f32x4 g = gr[64 * j]; o8[64 * j] = (unsigned long long)pk2(v[j].x * rstd * g.x, v[j].y * rstd * g.y) | ((unsigned long long)pk2(v[j].z * rstd * g.z, v[j].w * rstd * g.w) << 32); }
}

struct Args { Ptrs P; int ph_lo, ph_hi, li, pad; };
__global__ void __launch_bounds__(NWAVES * 64, 2) mega(Args args) {
    extern __shared__ __attribute__((aligned(16))) unsigned char lds[];
    LAS unsigned char* L = (LAS unsigned char*)lds;
    volatile LAS unsigned* MISC = (volatile LAS unsigned*)(L + MISC_OFF);
    const int tid = threadIdx.x, lane = tid & 63, wave = __builtin_amdgcn_readfirstlane(tid >> 6);
    const int G = gridDim.x; const int bx = blockIdx.x; const int vcu = (G % 8 == 0) ? (bx % 8) * (G / 8) + bx / 8 : bx;
    const Ptrs& P = args.P; unsigned char* ws = P.ws;
    gu32* ctl = (gu32*)(ws + WS_CTL);
    for (int u = tid; u < (LDS_BYTES - LDSCTL_OFF) / 4; u += NWAVES * 64) ((LAS unsigned*)(L + LDSCTL_OFF))[u] = 0u;
    __syncthreads();
    const int lo = args.ph_lo, hi = args.ph_hi;
    XcdBarrier bar; bar.bar = (unsigned*)(ctl + CW_BAR) + args.li * XCD_BAR_WORDS; bar.x = 0; bar.st = nullptr;
    if (hi - lo > 1) bar = xcd_barrier_post((unsigned*)(ctl + CW_BAR) + args.li * XCD_BAR_WORDS, MISC + 8);
#ifndef PH_ENABLE
#define PH_ENABLE 63
#endif
#define IN(k) (((PH_ENABLE >> (k)) & 1) && lo <= (k) && (k) < hi)
    bf16_t* Hb = (bf16_t*)(ws + WS_H); bf16_t* WinT = (bf16_t*)(ws + WS_WIN); bf16_t* WabT = (bf16_t*)(ws + WS_WAB); bf16_t* WoT = (bf16_t*)(ws + WS_WO);

    if (IN(0)) {
        LAS float* scr = (LAS float*)(L + RING_OFF + wave * 16384);
        const int gw = vcu * NWAVES + wave, NGW = G * NWAVES;
        constexpr int I_IN = (DM / 64) * (NIN / 32), I_AB = (1024 / 64) * (DM / 32), I_O = (DM / 64) * (DM / 32);
        constexpr int NITEMS = I_IN + 2 * I_AB + I_O;
        for (int it = gw; it < NITEMS; it += NGW) {
            int r = it;
            if (r < I_IN) { const int n0 = 32 * (r % (NIN / 32)); p0_transpose_item(P.w_in, NIN, WinT, DM, 0, (n0 >= C_GQQ && n0 < C_GQV) ? 2 : 1, scr, r, lane); continue; } r -= I_IN;
            if (r < I_AB) { p0_transpose_item(P.w_a, DM, WabT, DM, 0, 1, scr, r, lane); continue; } r -= I_AB;
            if (r < I_AB) { p0_transpose_item(P.w_b, DM, WabT, DM, 1024, 1, scr, r, lane); continue; } r -= I_AB;
            p0_transpose_item(P.w_out, DM, WoT, DM, 0, 0, scr, r, lane);
        }
        for (int m = gw; m < M; m += NGW) rms_row_to_bf16(m < MP ? P.xp + (size_t)m * DM : P.xs + (size_t)(m - MP) * DM, P.norm_g, Hb + (size_t)m * DM, lane);
        const int gt = vcu * (NWAVES * 64) + tid, NGT = G * NWAVES * 64;
        for (int i = gt; i < 128 * 32; i += NGT) { const int pos = i >> 5, f = i & 31; const float ang = (float)pos * powf(10000.0f, -(float)(2 * f) / 64.0f);
            float* T = (float*)(ws + WS_ROPE); T[i] = cosf(ang); T[4096 + i] = sinf(ang); }
        {
            const float gq = wave_max(fmaxf(fabsf(P.na_q_g[lane]), fabsf(P.na_q_g[lane + 64]))), gk = wave_max(fmaxf(fabsf(P.na_k_g[lane]), fabsf(P.na_k_g[lane + 64])));
            const float Bna = QSCALE * 128.0f * gq * gk;
            f32x4* BT = (f32x4*)(ws + WS_BIAS);
            for (int e = gt; e < 8 * 15 * 2 * 8 * 64; e += NGT) {
                const int ln = e & 63, i = (e >> 6) & 7, half = (e >> 9) & 1, hd = e >> 10;
                const int c = 32 * half + (ln & 31), kc0 = 32 * (i >> 2) + 8 * (i & 3) + 4 * (ln >> 5);
                int cs = c - 8; cs = cs < 0 ? 0 : (cs > 48 ? 48 : cs);
                f32x4 v;
#pragma unroll
                for (int q = 0; q < 4; ++q) { const int kc = kc0 + q; const bool valid = (kc >= cs) && (kc < cs + 16); const int idx = valid ? (kc - c + 15) : 15;
                    const float b = P.na_rpb[hd * 31 + idx] * LOG2E - Bna; v[q] = valid ? b : -30000.0f; }
                BT[e] = v;
            }
        }
        if (IN(1)) xcd_barrier(bar);
    }
    if (IN(1)) {
        pg8::Gemm g{Hb, WinT, M, NIN, DM}; pg8::StaticOrder S; S.init(M, NIN, G, bx);
        pg8::EpiA E{P, (LAS float*)(L + XCH_OFF)};
        pg8::gemm_phase<pg8::EpiA, pg8::StaticOrder, true, true>(L + RING_OFF, g, S, E);
        if (IN(2) || IN(3)) xcd_barrier(bar);
    }
    if (IN(2)) {
        const bf16_t* QB = (const bf16_t*)(ws + WS_QB); const bf16_t* KB = (const bf16_t*)(ws + WS_KB); const bf16_t* VB = (const bf16_t*)(ws + WS_VB); const bf16_t* ZB = (const bf16_t*)(ws + WS_ZB);
        bf16_t* OB = (bf16_t*)(ws + WS_OAB) + 1024;
        for (int p = vcu; p < 256; p += G) { const int h = p >> 5, qb = p & 31; const size_t m0 = (size_t)qb * 256;
            att::gqa_unit(QB + m0 * 1024 + h * 128, KB + (h >> 2) * 128, VB + (h >> 2) * 128, ZB + m0 * 1024 + h * 128, OB + m0 * 2048 + h * 128, 8192, (char*)lds); }
        for (int s = vcu; s < 512; s += G) { const int sq = s >> 6, h = (s >> 3) & 7, qb = s & 7; const size_t t0 = (size_t)MP + (size_t)sq * 2048, m0 = t0 + (size_t)qb * 256;
            att::gqa_unit(QB + m0 * 1024 + h * 128, KB + t0 * 256 + (h >> 2) * 128, VB + t0 * 256 + (h >> 2) * 128, ZB + m0 * 1024 + h * 128, OB + m0 * 2048 + h * 128, 2048, (char*)lds); }
    }
    if (IN(3)) {
        const bf16_t* QA = (const bf16_t*)(ws + WS_QA); const bf16_t* KA = (const bf16_t*)(ws + WS_KA); const bf16_t* VA = (const bf16_t*)(ws + WS_VA); const bf16_t* ZA = (const bf16_t*)(ws + WS_ZA);
        bf16_t* OA = (bf16_t*)(ws + WS_OAB);
        for (int n = vcu; n < 768; n += G) { const int h = (n >> 5) & 7, tb = (n >> 8) * 32 + (n & 31), m0 = tb * 256;
            const int s0 = m0 < MP ? 0 : MP + (((m0 - MP) >> 11) << 11), R = m0 < MP ? 128 : 32;
            att::na_unit(QA, KA, VA, ZA, OA, (const float*)(ws + WS_BIAS), m0, s0, R, h, (char*)lds); }
        __syncthreads();
    }
    if ((IN(2) || IN(3)) && IN(4)) xcd_barrier(bar);
    if (IN(4)) {
        pg8::Gemm g{(const bf16_t*)(ws + WS_OAB), WabT, M, DM, DM}; pg8::StaticOrder S; S.init(M, DM, G, bx);
        pg8::EpiC1 E{(const bf16_t*)P.out, (const bf16_t*)P.out + (size_t)M * DM, (bf16_t*)(ws + WS_MG)};
        pg8::gemm_phase<pg8::EpiC1, pg8::StaticOrder, true, true>(L + RING_OFF, g, S, E);
        if (IN(5)) xcd_barrier(bar);
    }
    if (IN(5)) {
        pg8::Gemm g{(const bf16_t*)(ws + WS_MG), WoT, M, DM, DM}; pg8::StaticOrder S; S.init(M, DM, G, bx);
        pg8::EpiC2 E{P.xp, P.xs, P.out};
        pg8::gemm_phase<pg8::EpiC2, pg8::StaticOrder, true, true>(L + RING_OFF, g, S, E);
    }
#undef IN
}

#define OPTMASK 31
#define ONE_LAUNCH 1
#ifndef OPTMASK
#define OPTMASK 31
#endif
#ifndef ONE_LAUNCH
#define ONE_LAUNCH 1
#endif
extern "C" void kernel_launch(void* const* d_in, const int* in_sizes, int n_in, void* d_out, int out_size, void* d_ws, size_t ws_size, hipStream_t stream) {
    static int grid = 0;
    if (grid == 0) {
        if (n_in != 13 || in_sizes[0] != MP * DM || in_sizes[1] != MS * DM || in_sizes[3] != DM * NIN || out_size != M * DM || ws_size < WS_END) {
            fprintf(stderr, "kernel_launch: shape mismatch n_in %d out %d ws %zu (need %zu)\n", n_in, out_size, ws_size, (size_t)WS_END); grid = -1; return; }
        int dev = 0, cus = 0, per_cu = 0;
        if (hipGetDevice(&dev) != hipSuccess || hipDeviceGetAttribute(&cus, hipDeviceAttributeMultiprocessorCount, dev) != hipSuccess) { fprintf(stderr, "kernel_launch: device query failed\n"); grid = -1; return; }
        if (hipFuncSetAttribute((const void*)mega, hipFuncAttributeMaxDynamicSharedMemorySize, LDS_BYTES) != hipSuccess) { fprintf(stderr, "kernel_launch: hipFuncSetAttribute failed\n"); grid = -1; return; }
        if (hipOccupancyMaxActiveBlocksPerMultiprocessor(&per_cu, (const void*)mega, NWAVES * 64, LDS_BYTES) != hipSuccess || per_cu < 1) { fprintf(stderr, "kernel_launch: occupancy query says %d blocks per CU\n", per_cu); }
        (void)hipGetLastError();
        grid = cus;
    }
    if (grid < 0) return;
    Ptrs P{};
    P.xp = (const float*)d_in[0]; P.xs = (const float*)d_in[1]; P.norm_g = (const float*)d_in[2]; P.w_in = (const float*)d_in[3];
    P.na_q_g = (const float*)d_in[4]; P.na_k_g = (const float*)d_in[5]; P.na_rpb = (const float*)d_in[6]; P.gq_q_g = (const float*)d_in[7]; P.gq_k_g = (const float*)d_in[8];
    P.w_a = (const float*)d_in[9]; P.w_b = (const float*)d_in[10]; P.gate_bias = (const float*)d_in[11]; P.w_out = (const float*)d_in[12];
    P.out = (float*)d_out; P.ws = (unsigned char*)d_ws;
    (void)hipMemsetAsync((char*)d_ws + WS_CTL, 0, CTL_ZERO_BYTES, stream);
    Args a{}; a.P = P;
    int li = 0;
#define MEGA(lo_, hi_) do { a.ph_lo = (lo_); a.ph_hi = (hi_); a.li = li++; hipLaunchKernelGGL(mega, dim3(grid), dim3(NWAVES * 64), LDS_BYTES, stream, a); } while (0)
    if (OPTMASK == 31 && ONE_LAUNCH) { MEGA(0, 6); }
    else {
        if (OPTMASK & 1) MEGA(0, 2);
        else { if (OPTMASK) MEGA(0, 1);
            hipLaunchKernelGGL(n_rms, dim3(M / 4), dim3(256), 0, stream, P); hipLaunchKernelGGL(n_rope_tab, dim3(16), dim3(256), 0, stream, P);
            hipLaunchKernelGGL(n_gemm1, dim3(M / 64, NIN / 128), dim3(256), 0, stream, P); }
        if (OPTMASK & 2) MEGA(2, 3); else hipLaunchKernelGGL(n_gqa, dim3(M * 8 / 4), dim3(256), 0, stream, P);
        if (OPTMASK & 4) MEGA(3, 4); else hipLaunchKernelGGL(n_na, dim3(M * 8 / 4), dim3(256), 0, stream, P);
        if (OPTMASK & 8) MEGA(4, 5); else hipLaunchKernelGGL(n_gemm2<0>, dim3(M / 64, DM / 64), dim3(256), 0, stream, P);
        if (OPTMASK & 16) MEGA(5, 6); else hipLaunchKernelGGL(n_gemm2<1>, dim3(M / 64, DM / 64), dim3(256), 0, stream, P);
    }
    const hipError_t le = hipPeekAtLastError();
    if (le != hipSuccess) fprintf(stderr, "kernel_launch: launch failed: %s\n", hipGetErrorName(le));
}
```

```cpp
#include <hip/hip_runtime.h>
#include <cstdio>
#include <cstdint>

constexpr int DM = 2048, MP = 8192, MS = 16384, M = MP + MS;
constexpr int NIN = 10752;
constexpr int C_NAQ = 0, C_NAK = 1024, C_NAV = 2048, C_NAZ = 3072, C_GQQ = 4096, C_GQK = 5120, C_GQV = 5376, C_GQZ = 5632, C_GA = 6656, C_GB = 8704;
constexpr float EPS = 1e-6f;
constexpr float QSCALE = 0.08838834764831845f * 1.4426950408889634f;
constexpr float LOG2E = 1.4426950408889634f;

typedef unsigned short bf16_t;
__device__ __forceinline__ float bf2f(bf16_t b) { return __uint_as_float(((unsigned)b) << 16); }
__device__ __forceinline__ bf16_t f2bf(float f) { unsigned u = __float_as_uint(f); u += 0x7fffu + ((u >> 16) & 1u); return (bf16_t)(u >> 16); }

constexpr size_t MiB = 1u << 20;
constexpr size_t WS_CTL = 0;
constexpr size_t WS_ROPE = 1 * MiB;
constexpr size_t WS_BIAS = 1 * MiB + 64 * 1024;
constexpr size_t WS_WIN = 3 * MiB;
constexpr size_t WS_WIN8 = 27 * MiB;
constexpr size_t WS_WAB = 40 * MiB, WS_WO = 48 * MiB;
constexpr size_t WS_H8 = 56 * MiB;
constexpr size_t WS_H = 104 * MiB;
constexpr size_t WS_OAB = WS_H;
constexpr size_t WS_QA = 200 * MiB, WS_KA = 248 * MiB, WS_VA = 296 * MiB, WS_ZA = 344 * MiB;
constexpr size_t WS_QB = 392 * MiB, WS_ZB = 440 * MiB;
constexpr size_t WS_KB = 488 * MiB, WS_VB = 500 * MiB;
constexpr size_t WS_MG = WS_QA;
constexpr size_t WS_END = 512 * MiB;

struct Ptrs {
    const float *xp, *xs, *norm_g, *w_in, *na_q_g, *na_k_g, *na_rpb, *gq_q_g, *gq_k_g, *w_a, *w_b, *gate_bias, *w_out;
    float* out; unsigned char* ws;
};
__device__ __forceinline__ const float* xrow(const Ptrs& P, int m) { return m < MP ? P.xp + (size_t)m * DM : P.xs + (size_t)(m - MP) * DM; }
__device__ __forceinline__ int seq_start(int m) { return m < MP ? 0 : MP + ((m - MP) >> 11 << 11); }
__device__ __forceinline__ int seq_rows(int m) { return m < MP ? 128 : 32; }

#ifndef DF_MODE
#define DF_MODE 0
#endif
namespace pg8 {
#define PG8_LAS __attribute__((address_space(3)))
typedef short bf16x8 __attribute__((ext_vector_type(8)));
typedef float f32x4 __attribute__((ext_vector_type(4)));
typedef unsigned u32x4 __attribute__((ext_vector_type(4)));
typedef unsigned u32x2 __attribute__((ext_vector_type(2)));
typedef float f32x2 __attribute__((ext_vector_type(2)));
constexpr int BM = 256, BK = 64, HALF = 128, HTB = HALF * BK * 2, STAGE_BYTES = 8 * HTB, NXCD = 8, WGM = 8;

__host__ __device__ __forceinline__ int lds_byte(int r, int c) { const int st = (r >> 4) * 2 + (c >> 5), rr = r & 15, cc = c & 31, ob = rr * 64 + cc * 2; return st * 1024 + (ob ^ (((ob >> 9) & 1) << 5)); }
__host__ __device__ __forceinline__ void stage_rc(int b, int& R, int& C) { const int st = b / 1024, sb = b % 1024, swz = sb ^ (((sb >> 9) & 1) << 5); R = (st >> 1) * 16 + swz / 64; C = (st & 1) * 32 + (swz % 64) / 2; }

struct Unit { int pm, pn, ri; };
struct Gemm { const bf16_t* A; const bf16_t* Bt; int M, N, K; };

struct StaticOrder {
    int nM, nN, nwg, G, c;
    __host__ __device__ void init(int M_, int N_, int G_, int c_) { nM = M_ / BM; nN = N_ / BM; nwg = nM * nN; G = G_; c = c_; }
    __host__ __device__ bool next(int i, Unit& u) const {
        const long L = (long)i * G + c; if (L >= nwg) return false;
        int wgid = (int)L; { const int q = nwg / NXCD, r = nwg % NXCD, xcd = wgid % NXCD, off = wgid / NXCD; wgid = (xcd < r ? xcd * (q + 1) : r * (q + 1) + (xcd - r) * q) + off; }
        const int nig = WGM * nN, gid = wgid / nig, fm = gid * WGM, gsz = (nM - fm) < WGM ? (nM - fm) : WGM;
        u.pm = fm + ((wgid % nig) % gsz); u.pn = (wgid % nig) / gsz; return true;
    }
    __device__ __forceinline__ void a_ready(const Unit&) const {}
    __device__ __forceinline__ void done(const Unit&) const {}
};

__device__ __forceinline__ unsigned cvt_pk_bf16(float lo, float hi) { unsigned r; asm volatile("v_cvt_pk_bf16_f32 %0, %1, %2" : "=v"(r) : "v"(lo), "v"(hi)); return r; }
__device__ __forceinline__ float bflo(unsigned w) { return __uint_as_float(w << 16); }
__device__ __forceinline__ float bfhi(unsigned w) { return __uint_as_float(w & 0xffff0000u); }
__device__ __forceinline__ float sigm(float v) { return __builtin_amdgcn_rcpf(1.0f + __builtin_amdgcn_exp2f(-v * LOG2E)); }

__device__ __forceinline__ void acc_zero(f32x4 (&acc)[2][2][4][2]) {
#pragma unroll
    for (int a = 0; a < 2; ++a)
#pragma unroll
        for (int b = 0; b < 2; ++b)
#pragma unroll
            for (int m = 0; m < 4; ++m)
#pragma unroll
                for (int n = 0; n < 2; ++n) acc[a][b][m][n] = (f32x4){0.f, 0.f, 0.f, 0.f};
}
enum { T_PLAIN = 0, T_SILU = 1, T_GATE = 2, T_NORM = 3, T_ROPE = 4 };
#ifndef FP8_GA
#define FP8_GA 1
#endif
constexpr int N16 = FP8_GA ? 16 : 24, N8 = 42 - N16;
__host__ __device__ __forceinline__ int pn_of16(int i) { return i < 16 ? i : 26 + (i - 16); }
__host__ __device__ __forceinline__ int pn_of8(int i) { return i < 10 ? 16 + i : (FP8_GA ? 26 + (i - 10) : 34 + (i - 10)); }
__host__ __device__ __forceinline__ bool pn_is8(int pn) { return (pn >= 16 && pn < 26) || pn >= 34 || (FP8_GA && pn >= 26); }
__host__ __device__ __forceinline__ int pn_idx(int pn) { return pn < 16 ? pn : (pn < 26 ? pn - 16 : (pn < 34 ? (FP8_GA ? 10 + pn - 26 : 16 + pn - 26) : (FP8_GA ? 10 + pn - 26 : 10 + pn - 34))); }
template <bool IS8> struct EpiA {
    static constexpr bool PERM = false, AFTER_DRAIN = false, HAS_MID = false; static constexpr int MID_T = 1 << 30;
    Ptrs P; PG8_LAS float* X;
    __device__ __forceinline__ void mid(f32x4 (&)[2][2][4][2], const Unit&, int, int, int, int) const {}
    __device__ __forceinline__ void second(f32x4 (&)[2][2][4][2], const Unit&, int, int, int, int) const {}
    __device__ __forceinline__ void init(f32x4 (&acc)[2][2][4][2], const Unit&, int, int, int, int) const { acc_zero(acc); }
    __device__ __forceinline__ void operator()(f32x4 (&acc)[2][2][4][2], const Unit& u, int wr, int wc, int fr, int fq) const {
        asm volatile("" : "+v"(fr), "+v"(fq));
        const int pn = IS8 ? pn_of8(u.pn) : pn_of16(u.pn); unsigned char* ws = P.ws;
        int type, ldc = 1024, coff; bf16_t* dst; const float* gw = P.na_q_g; float gs = 1.f; const float* bias = P.gate_bias;
        if (!IS8 && pn < 4)        { type = T_NORM;  dst = (bf16_t*)(ws + WS_QA); coff = pn * 256; gw = P.na_q_g; gs = QSCALE; }
        else if (!IS8 && pn < 8)   { type = T_NORM;  dst = (bf16_t*)(ws + WS_KA); coff = (pn - 4) * 256; gw = P.na_k_g; }
        else if (!IS8 && pn < 12)  { type = T_PLAIN; dst = (bf16_t*)(ws + WS_VA); coff = (pn - 8) * 256; }
        else if (!IS8 && pn < 16)  { type = T_SILU;  dst = (bf16_t*)(ws + WS_ZA); coff = (pn - 12) * 256; }
        else if (IS8 && pn < 20)  { type = T_ROPE;  dst = (bf16_t*)(ws + WS_QB); coff = (pn - 16) * 256; gw = P.gq_q_g; gs = QSCALE * 8.0f; }
        else if (IS8 && pn == 20) { type = T_ROPE;  dst = (bf16_t*)(ws + WS_KB); coff = 0; ldc = 256; gw = P.gq_k_g; }
        else if (IS8 && pn == 21) { type = T_PLAIN; dst = (bf16_t*)(ws + WS_VB); coff = 0; ldc = 256; }
        else if (IS8 && pn < 26)  { type = T_SILU;  dst = (bf16_t*)(ws + WS_ZB); coff = (pn - 22) * 256; }
        else if (pn < 34)  { type = T_GATE;  dst = (bf16_t*)P.out; coff = (pn - 26) * 256; ldc = 2048; bias = P.gate_bias + coff; }
        else               { type = T_GATE;  dst = (bf16_t*)P.out + (size_t)M * DM; coff = (pn - 34) * 256; ldc = 2048; bias = P.gate_bias + 2048 + coff; }
        const int row0 = u.pm * BM + wr * 64 + fr, c8 = wc * 32 + 8 * fq;
        if (type <= T_GATE) {
            f32x4 bv[2][2];
#pragma unroll
            for (int bj = 0; bj < 2; ++bj)
#pragma unroll
                for (int n = 0; n < 2; ++n) bv[bj][n] = (type == T_GATE) ? *(const f32x4*)(bias + bj * HALF + c8 + 4 * n) : (f32x4){0.f, 0.f, 0.f, 0.f};
            if (type == T_GATE && pn >= 34) {
#pragma unroll
                for (int ai = 0; ai < 2; ++ai)
#pragma unroll
                    for (int bj = 0; bj < 2; ++bj)
#pragma unroll
                        for (int mp = 0; mp < 2; ++mp) { unsigned q_[2][2];
#pragma unroll
                            for (int e = 0; e < 2; ++e) { const int m = 2 * mp + e; f32x4 v0 = acc[ai][bj][m][0] + bv[bj][0], v1 = acc[ai][bj][m][1] + bv[bj][1];
#pragma unroll
                                for (int j = 0; j < 4; ++j) { v0[j] = sigm(v0[j]); v1[j] = sigm(v1[j]); }
                                unsigned t0_ = 0, t1_ = 0;
                                t0_ = __builtin_amdgcn_cvt_pk_fp8_f32(v0[0], v0[1], t0_, false); t0_ = __builtin_amdgcn_cvt_pk_fp8_f32(v0[2], v0[3], t0_, true);
                                t1_ = __builtin_amdgcn_cvt_pk_fp8_f32(v1[0], v1[1], t1_, false); t1_ = __builtin_amdgcn_cvt_pk_fp8_f32(v1[2], v1[3], t1_, true);
                                q_[e][0] = t0_; q_[e][1] = t1_; }
                            auto r0_ = __builtin_amdgcn_permlane16_swap(q_[0][0], q_[1][0], false, false); auto r1_ = __builtin_amdgcn_permlane16_swap(q_[0][1], q_[1][1], false, false);
                            u32x4 w; w.x = r0_[0]; w.y = r1_[0]; w.z = r0_[1]; w.w = r1_[1];
                            *(u32x4*)((unsigned char*)dst + (size_t)(row0 + ai * HALF + (2 * mp + (fq & 1)) * 16) * 2048 + coff + wc * 32 + 16 * (fq >> 1) + bj * HALF) = w; }
            } else
#pragma unroll
            for (int ai = 0; ai < 2; ++ai)
#pragma unroll
                for (int m = 0; m < 4; ++m) { bf16_t* rowp = dst + (size_t)(row0 + ai * HALF + m * 16) * ldc + coff + c8;
#pragma unroll
                    for (int bj = 0; bj < 2; ++bj) { f32x4 v0 = acc[ai][bj][m][0] + bv[bj][0], v1 = acc[ai][bj][m][1] + bv[bj][1];
                        if (type == T_SILU) {
#pragma unroll
                            for (int j = 0; j < 4; ++j) { v0[j] = v0[j] * sigm(v0[j]); v1[j] = v1[j] * sigm(v1[j]); } }
                        if (type == T_GATE) {
#pragma unroll
                            for (int j = 0; j < 4; ++j) { v0[j] = sigm(v0[j]); v1[j] = sigm(v1[j]); } }
                        {
                        u32x4 w; w.x = cvt_pk_bf16(v0[0], v0[1]); w.y = cvt_pk_bf16(v0[2], v0[3]); w.z = cvt_pk_bf16(v1[0], v1[1]); w.w = cvt_pk_bf16(v1[2], v1[3]);
                        *(u32x4*)(rowp + bj * HALF) = w; } } }
        } else {
            const int trow = wr * 64 + fr;
            const int sec = wc >> 1, i0 = 16 * (wc & 1) + 4 * fq, d0 = 64 * sec + i0;
            f32x4 gA, gB, csT[2][4], snT[2][4];
            if (!IS8) { gA = *(const f32x4*)(gw + c8); gB = *(const f32x4*)(gw + c8 + 4); }
            else { gA = *(const f32x4*)(gw + d0); gB = *(const f32x4*)(gw + d0 + 32);
                const int t0 = u.pm * BM, s0 = t0 < MP ? 0 : MP + (((t0 - MP) >> 11) << 11), gr0 = ((t0 - s0) >> 6) + wr;
                const float* RT = (const float*)(ws + WS_ROPE);
#pragma unroll
                for (int ai = 0; ai < 2; ++ai)
#pragma unroll
                    for (int m = 0; m < 4; ++m) { const int p = sec ? (m * 16 + fr) : (gr0 + 2 * ai); csT[ai][m] = *(const f32x4*)(RT + p * 32 + i0); snT[ai][m] = *(const f32x4*)(RT + 4096 + p * 32 + i0); } }
#pragma unroll
            for (int ai = 0; ai < 2; ++ai)
#pragma unroll
                for (int m = 0; m < 4; ++m)
#pragma unroll
                    for (int bj = 0; bj < 2; ++bj) { const f32x4 a = acc[ai][bj][m][0], b = acc[ai][bj][m][1];
                        float s = (a[0] * a[0] + a[1] * a[1]) + (a[2] * a[2] + a[3] * a[3]) + (b[0] * b[0] + b[1] * b[1]) + (b[2] * b[2] + b[3] * b[3]);
                        s += __shfl_xor(s, 16); s += __shfl_xor(s, 32);
                        if (fq == 0) X[(ai * HALF + m * 16 + trow) * 8 + bj * 4 + wc] = s; }
            asm volatile("s_waitcnt lgkmcnt(0)" ::: "memory"); __builtin_amdgcn_s_barrier(); asm volatile("" ::: "memory");
            if (!IS8 && type == T_NORM) {
                f32x4 g0 = gA * gs, g1 = gB * gs;
#pragma unroll
                for (int ai = 0; ai < 2; ++ai)
#pragma unroll
                    for (int m = 0; m < 4; ++m) { bf16_t* rowp = dst + (size_t)(row0 + ai * HALF + m * 16) * ldc + coff + c8;
#pragma unroll
                        for (int bj = 0; bj < 2; ++bj) { const f32x4 t = *(const PG8_LAS f32x4*)(X + (ai * HALF + m * 16 + trow) * 8 + bj * 4);
                            const float rstd = __builtin_amdgcn_rsqf(((t[0] + t[1]) + (t[2] + t[3])) * (1.0f / 128.0f) + EPS);
                            const f32x4 v0 = acc[ai][bj][m][0] * g0 * rstd, v1 = acc[ai][bj][m][1] * g1 * rstd;
                            u32x4 w; w.x = cvt_pk_bf16(v0[0], v0[1]); w.y = cvt_pk_bf16(v0[2], v0[3]); w.z = cvt_pk_bf16(v1[0], v1[1]); w.w = cvt_pk_bf16(v1[2], v1[3]);
                            *(u32x4*)(rowp + bj * HALF) = w; } }
            } else if (IS8) {
                const f32x4 g1 = gA * gs, g2 = gB * gs;
#define TR4(K) do { auto s0_ = __builtin_amdgcn_permlane32_swap(K[0], K[2], false, false); auto s1_ = __builtin_amdgcn_permlane32_swap(K[1], K[3], false, false); \
                    auto t0_ = __builtin_amdgcn_permlane16_swap(s0_[0], s1_[0], false, false); auto t1_ = __builtin_amdgcn_permlane16_swap(s0_[1], s1_[1], false, false); \
                    K[0] = t0_[0]; K[1] = t0_[1]; K[2] = t1_[0]; K[3] = t1_[1]; } while (0)
                const int dbase = 64 * sec + 16 * (wc & 1);
#pragma unroll
                for (int ai = 0; ai < 2; ++ai)
#pragma unroll
                    for (int bj = 0; bj < 2; ++bj) { unsigned K1[4], K2[4];
#pragma unroll
                        for (int m = 0; m < 4; ++m) { const f32x4 cs = csT[ai][m], sn = snT[ai][m];
                            const f32x4 t = *(const PG8_LAS f32x4*)(X + (ai * HALF + m * 16 + trow) * 8 + bj * 4);
                            const float rstd = __builtin_amdgcn_rsqf(((t[0] + t[1]) + (t[2] + t[3])) * (1.0f / 128.0f) + EPS);
                            const f32x4 x1 = acc[ai][bj][m][0] * g1 * rstd, x2 = acc[ai][bj][m][1] * g2 * rstd;
                            const f32x4 y1 = x1 * cs - x2 * sn, y2 = x2 * cs + x1 * sn;
                            unsigned k1 = 0, k2 = 0; k1 = __builtin_amdgcn_cvt_pk_fp8_f32(y1[0], y1[1], k1, false); k1 = __builtin_amdgcn_cvt_pk_fp8_f32(y1[2], y1[3], k1, true);
                            k2 = __builtin_amdgcn_cvt_pk_fp8_f32(y2[0], y2[1], k2, false); k2 = __builtin_amdgcn_cvt_pk_fp8_f32(y2[2], y2[3], k2, true);
                            K1[m] = k1; K2[m] = k2; }
                        TR4(K1); TR4(K2);
                        const size_t orow = (size_t)(row0 + ai * HALF + fq * 16);
                        unsigned char* r8 = (pn == 20 ? (unsigned char*)(ws + WS_KB) + orow * 256 : (unsigned char*)(ws + WS_QB) + orow * 1024 + coff) + dbase + bj * HALF;
                        u32x4 w1, w2; w1.x = K1[0]; w1.y = K1[1]; w1.z = K1[2]; w1.w = K1[3]; w2.x = K2[0]; w2.y = K2[1]; w2.z = K2[2]; w2.w = K2[3];
                        *(u32x4*)r8 = w1; *(u32x4*)(r8 + 32) = w2; }
#undef TR4
            }
        }
    }
};
struct EpiC1 {
    static constexpr bool PERM = false, AFTER_DRAIN = false, HAS_MID = true; static constexpr int MID_T = 16;
    const bf16_t* GA; const unsigned char* GB; bf16_t* MG;
    static __device__ __forceinline__ void unp8(u32x2 w, f32x4& e0, f32x4& e1) {
        const f32x2 a = __builtin_amdgcn_cvt_pk_f32_fp8(w.x, false), b = __builtin_amdgcn_cvt_pk_f32_fp8(w.x, true), c = __builtin_amdgcn_cvt_pk_f32_fp8(w.y, false), d = __builtin_amdgcn_cvt_pk_f32_fp8(w.y, true);
        e0 = (f32x4){a.x, a.y, b.x, b.y}; e1 = (f32x4){c.x, c.y, d.x, d.y}; }
    __device__ __forceinline__ void second(f32x4 (&)[2][2][4][2], const Unit&, int, int, int, int) const {}
    __device__ __forceinline__ void init(f32x4 (&acc)[2][2][4][2], const Unit&, int, int, int, int) const { acc_zero(acc); }
    __device__ __forceinline__ void mid(f32x4 (&acc)[2][2][4][2], const Unit& u, int wr, int wc, int fr, int fq) const {
        asm volatile("" : "+v"(fr), "+v"(fq));
        const size_t off0 = (size_t)(u.pm * BM + wr * 64 + fr) * DM + u.pn * BM + wc * 32 + 8 * fq;
#pragma unroll
        for (int ai = 0; ai < 2; ++ai) {
            u32x4 a[4][2]; u32x2 b[4][2];
#pragma unroll
            for (int m = 0; m < 4; ++m)
#pragma unroll
                for (int bj = 0; bj < 2; ++bj) { const size_t off = off0 + (size_t)(ai * HALF + m * 16) * DM + bj * HALF; a[m][bj] = *(const u32x4*)(GA + off); b[m][bj] = *(const u32x2*)(GB + off); }
#pragma unroll
            for (int m = 0; m < 4; ++m)
#pragma unroll
                for (int bj = 0; bj < 2; ++bj) { const u32x4 av = a[m][bj]; f32x4 g0, g1; unp8(b[m][bj], g0, g1);
                    f32x4 r0, r1;
                    r0[0] = bflo(av.x) * __builtin_amdgcn_rcpf(g0[0]); r0[1] = bfhi(av.x) * __builtin_amdgcn_rcpf(g0[1]);
                    r0[2] = bflo(av.y) * __builtin_amdgcn_rcpf(g0[2]); r0[3] = bfhi(av.y) * __builtin_amdgcn_rcpf(g0[3]);
                    r1[0] = bflo(av.z) * __builtin_amdgcn_rcpf(g1[0]); r1[1] = bfhi(av.z) * __builtin_amdgcn_rcpf(g1[1]);
                    r1[2] = bflo(av.w) * __builtin_amdgcn_rcpf(g1[2]); r1[3] = bfhi(av.w) * __builtin_amdgcn_rcpf(g1[3]);
                    acc[ai][bj][m][0] = acc[ai][bj][m][0] * (r0 * 4096.0f); acc[ai][bj][m][1] = acc[ai][bj][m][1] * (r1 * 4096.0f); }
            asm volatile("" ::: "memory");
        }
    }
    __device__ __forceinline__ void operator()(f32x4 (&acc)[2][2][4][2], const Unit& u, int wr, int wc, int fr, int fq) const {
        asm volatile("" : "+v"(fr), "+v"(fq));
        const size_t off0 = (size_t)(u.pm * BM + wr * 64 + fr) * DM + u.pn * BM + wc * 32 + 8 * fq;
        u32x2 b[2][4][2];
#pragma unroll
        for (int ai = 0; ai < 2; ++ai)
#pragma unroll
            for (int m = 0; m < 4; ++m)
#pragma unroll
                for (int bj = 0; bj < 2; ++bj) b[ai][m][bj] = *(const u32x2*)(GB + off0 + (size_t)(ai * HALF + m * 16) * DM + bj * HALF);
#pragma unroll
        for (int ai = 0; ai < 2; ++ai)
#pragma unroll
            for (int m = 0; m < 4; ++m)
#pragma unroll
                for (int bj = 0; bj < 2; ++bj) { const size_t off = off0 + (size_t)(ai * HALF + m * 16) * DM + bj * HALF; f32x4 g0, g1; unp8(b[ai][m][bj], g0, g1);
                    const f32x4 v0 = acc[ai][bj][m][0] * (g0 * (1.0f / 4096.0f)), v1 = acc[ai][bj][m][1] * (g1 * (1.0f / 4096.0f));
                    u32x4 w; w.x = cvt_pk_bf16(v0[0], v0[1]); w.y = cvt_pk_bf16(v0[2], v0[3]); w.z = cvt_pk_bf16(v1[0], v1[1]); w.w = cvt_pk_bf16(v1[2], v1[3]);
                    *(u32x4*)(MG + off) = w; }
    }
};
struct EpiC2 {
    static constexpr bool PERM = false, AFTER_DRAIN = false, HAS_MID = false; static constexpr int MID_T = 1 << 30;
    const float* xp; const float* xs; float* out; float pscale;
    __device__ __forceinline__ void second(f32x4 (&)[2][2][4][2], const Unit&, int, int, int, int) const {}
    __device__ __forceinline__ void mid(f32x4 (&)[2][2][4][2], const Unit&, int, int, int, int) const {}
    __device__ __forceinline__ void init(f32x4 (&acc)[2][2][4][2], const Unit& u, int wr, int wc, int fr, int fq) const {
        asm volatile("" : "+v"(fr), "+v"(fq));
        const int col0 = u.pn * BM + wc * 32 + 4 * fq, grow0 = u.pm * BM + wr * 64 + fr;
        const float* xb = (grow0 < MP ? xp + (size_t)grow0 * DM : xs + (size_t)(grow0 - MP) * DM) + col0;
#pragma unroll
        for (int ai = 0; ai < 2; ++ai)
#pragma unroll
            for (int m = 0; m < 4; ++m)
#pragma unroll
                for (int bj = 0; bj < 2; ++bj)
#pragma unroll
                    for (int n = 0; n < 2; ++n) acc[ai][bj][m][n] = __builtin_nontemporal_load((const f32x4*)(xb + (size_t)(ai * HALF + m * 16) * DM + bj * HALF + n * 16));
    }
    __device__ __forceinline__ void operator()(f32x4 (&acc)[2][2][4][2], const Unit& u, int wr, int wc, int fr, int fq) const {
        asm volatile("" : "+v"(fr), "+v"(fq));
        const int col0 = u.pn * BM + wc * 32 + 4 * fq, grow0 = u.pm * BM + wr * 64 + fr;
        float* ob = out + (size_t)grow0 * DM + col0;
#pragma unroll
        for (int ai = 0; ai < 2; ++ai)
#pragma unroll
            for (int m = 0; m < 4; ++m)
#pragma unroll
                for (int bj = 0; bj < 2; ++bj)
#pragma unroll
                    for (int n = 0; n < 2; ++n) __builtin_nontemporal_store(
#ifdef PROBE_T
                        acc[ai][bj][m][n] * pscale,
#else
                        acc[ai][bj][m][n],
#endif
                        (f32x4*)(ob + (size_t)(ai * HALF + m * 16) * DM + bj * HALF + n * 16));
    }
};

typedef int i32x8 __attribute__((ext_vector_type(8)));
typedef int i32x4 __attribute__((ext_vector_type(4)));
__device__ __forceinline__ bf16x8 lo8(i32x8 v) { return __builtin_bit_cast(bf16x8, (i32x4)__builtin_shufflevector(v, v, 0, 1, 2, 3)); }
__device__ __forceinline__ bf16x8 hi8(i32x8 v) { return __builtin_bit_cast(bf16x8, (i32x4)__builtin_shufflevector(v, v, 4, 5, 6, 7)); }
__device__ __forceinline__ i32x8 cat8(bf16x8 a, bf16x8 b) { return __builtin_shufflevector(__builtin_bit_cast(i32x4, a), __builtin_bit_cast(i32x4, b), 0, 1, 2, 3, 4, 5, 6, 7); }
template <class Epi, class Sched, bool ALIGN_EPI = false, bool SP2 = false, bool FP8 = false, bool MIX = false>
__device__ __forceinline__ void gemm_phase(PG8_LAS unsigned char* lds, const Gemm g, const Sched& S, const Epi& E) {
    const int tid = threadIdx.x, wid = __builtin_amdgcn_readfirstlane(tid >> 6), lane = tid & 63, wr = wid >> 2, wc = wid & 3, fr = lane & 15, fq = lane >> 4;
    const int K = g.K, nt = K / BK;
    unsigned voffA[2];
#pragma unroll
    for (int i = 0; i < 2; ++i) { int R, C; stage_rc(tid * 16 + i * 8192, R, C); voffA[i] = (unsigned)(R * K + C) * 2u; }
#define voffB voffA
    const size_t kstep = (size_t)(BK * 2);
    const size_t hstep = (size_t)HALF * K * 2;
    const size_t tstep = 2 * hstep;
    const unsigned ldsw = (unsigned)wid * 1024u;
    const int aoff = lds_byte(wr * 64 + fr, fq * 8), boff = lds_byte(wc * 32 + fr, fq * 8);
#define PG8_SA(b, h) (((b) * 2 + (h)) * HTB)
#define PG8_SB(b, h) ((4 + (b) * 2 + (h)) * HTB)
#define PG8_STAGE(bufoff, gbase, voff) do { _Pragma("unroll") for (int _i = 0; _i < 2; ++_i) \
        __builtin_amdgcn_global_load_lds((const unsigned*)((const char*)(gbase) + (voff)[_i]), (PG8_LAS unsigned*)(lds + (bufoff) + ldsw + _i * 8192), 16, 0, 0); } while (0)
#define PG8_LDA8_(dst, b, h) do { _Pragma("unroll") for (int m = 0; m < 4; ++m) dst##8[m] = cat8(*(const PG8_LAS bf16x8*)(lds + PG8_SA(b, h) + aoff + m * 2048), *(const PG8_LAS bf16x8*)(lds + PG8_SA(b, h) + aoff + m * 2048 + 1024)); } while (0)
#define PG8_LDA16_(dst, b, h) do { _Pragma("unroll") for (int m = 0; m < 4; ++m) _Pragma("unroll") for (int k = 0; k < 2; ++k) dst[m][k] = *(const PG8_LAS bf16x8*)(lds + PG8_SA(b, h) + aoff + m * 2048 + k * 1024); } while (0)
#define PG8_LDB8_(dst, b, h) do { _Pragma("unroll") for (int n = 0; n < 2; ++n) dst##8[n] = cat8(*(const PG8_LAS bf16x8*)(lds + PG8_SB(b, h) + boff + n * 2048), *(const PG8_LAS bf16x8*)(lds + PG8_SB(b, h) + boff + n * 2048 + 1024)); } while (0)
#define PG8_LDB16_(dst, b, h) do { _Pragma("unroll") for (int n = 0; n < 2; ++n) _Pragma("unroll") for (int k = 0; k < 2; ++k) dst[n][k] = *(const PG8_LAS bf16x8*)(lds + PG8_SB(b, h) + boff + n * 2048 + k * 1024); } while (0)
#define PG8_LDA(F8, dst, b, h) do { if constexpr (F8) PG8_LDA8_(dst, b, h); else PG8_LDA16_(dst, b, h); } while (0)
#define PG8_LDB(F8, dst, b, h) do { if constexpr (F8) PG8_LDB8_(dst, b, h); else PG8_LDB16_(dst, b, h); } while (0)
#define PG8_MMA8(ai, bj, At, Bt) do { _Pragma("unroll") for (int m = 0; m < 4; ++m) _Pragma("unroll") for (int n = 0; n < 2; ++n) \
        asm volatile("v_mfma_scale_f32_16x16x128_f8f6f4 %0, %1, %2, %0, %3, %3 op_sel_hi:[0,0,0]" : "+v"(acc[ai][bj][m][n]) : "v"(Bt##8[n]), "v"(At##8[m]), "v"(sc8)); } while (0)
#define PG8_MMA16_(ai, bj, At, Bt) do { _Pragma("unroll") for (int m = 0; m < 4; ++m) _Pragma("unroll") for (int n = 0; n < 2; ++n) _Pragma("unroll") for (int k = 0; k < 2; ++k) \
        acc[ai][bj][m][n] = __builtin_amdgcn_mfma_f32_16x16x32_bf16(Bt[n][k], At[m][k], acc[ai][bj][m][n], 0, 0, 0); } while (0)
#define PG8_MMA(F8, ai, bj, At, Bt) do { __builtin_amdgcn_s_setprio(1); if constexpr (F8) { PG8_MMA8(ai, bj, At, Bt); } else { PG8_MMA16_(ai, bj, At, Bt); } __builtin_amdgcn_s_setprio(0); } while (0)
#define PG8_WAIT_V(n) asm volatile("s_waitcnt vmcnt(" #n ")" ::: "memory")
#define PG8_WAIT_L(n) asm volatile("s_waitcnt lgkmcnt(" #n ")" ::: "memory")
#define PG8_BAR __builtin_amdgcn_s_barrier()
#define PG8_SCHED __builtin_amdgcn_sched_barrier(0)
    Unit cur, nxt; int ui = 0;
    if (!S.next(0, cur)) return;
    f32x4 acc[2][2][4][2];
    E.init(acc, cur, wr, wc, fr, fq);
    bf16x8 At[4][2], B0[2][2], B1[2][2]; i32x8 At8[4], B08[2], B18[2]; int sc8 = (FP8 && !MIX) ? 0x7c7c7c7c : 0x7f7f7f7f; asm volatile("" : "+v"(sc8));
    const char* cA = (const char*)g.A + (size_t)cur.pm * tstep; const char* cB = (const char*)g.Bt + (size_t)cur.pn * tstep;
    S.a_ready(cur);
    if constexpr (SP2) {
        PG8_STAGE(PG8_SB(0, 0), cB, voffB); PG8_STAGE(PG8_SB(0, 1), cB + hstep, voffB); PG8_STAGE(PG8_SA(0, 0), cA, voffA); PG8_STAGE(PG8_SA(0, 1), cA + hstep, voffA);
        if (wr == 1) PG8_BAR;
        PG8_WAIT_V(2); PG8_BAR;
        PG8_STAGE(PG8_SB(1, 0), cB + kstep, voffB); PG8_STAGE(PG8_SA(1, 0), cA + kstep, voffA); PG8_STAGE(PG8_SB(1, 1), cB + hstep + kstep, voffB);
        PG8_WAIT_V(6); PG8_BAR;
    } else {
        PG8_STAGE(PG8_SB(0, 0), cB, voffB); PG8_STAGE(PG8_SA(0, 0), cA, voffA); PG8_STAGE(PG8_SB(0, 1), cB + hstep, voffB); PG8_STAGE(PG8_SA(0, 1), cA + hstep, voffA);
        if (wr == 1) PG8_BAR;
        PG8_WAIT_V(4); PG8_BAR;
        PG8_STAGE(PG8_SB(1, 0), cB + kstep, voffB); PG8_STAGE(PG8_SA(1, 0), cA + kstep, voffA); PG8_STAGE(PG8_SB(1, 1), cB + hstep + kstep, voffB);
        PG8_WAIT_V(6); PG8_BAR;
    }
    for (;;) {
        const bool has_next = S.next(ui + 1, nxt);
        const char* nA = has_next ? (const char*)g.A + (size_t)nxt.pm * tstep : cA; const char* nB = has_next ? (const char*)g.Bt + (size_t)nxt.pn * tstep : cB;
#define PG8_ITER(F8) { \
            const bool last = (t == nt - 2); \
            const char* a1 = cA + (size_t)(t + 1) * kstep; \
            const char* a2 = last ? nA : cA + (size_t)(t + 2) * kstep; const char* b2 = last ? nB : cB + (size_t)(t + 2) * kstep; \
            const char* a3 = a2 + kstep; const char* b3 = b2 + kstep; \
            if (last && has_next) S.a_ready(nxt); \
            PG8_LDB(F8, B0, 0, 0); PG8_LDB(F8, B1, 0, 1); PG8_SCHED; PG8_LDA(F8, At, 0, 0); PG8_STAGE(PG8_SA(1, 1), a1 + hstep, voffA); \
            PG8_WAIT_V(8); PG8_WAIT_L(0); PG8_BAR; PG8_MMA(F8, 0, 0, At, B0); PG8_MMA(F8, 0, 1, At, B1); PG8_BAR; PG8_SCHED; \
            PG8_LDA(F8, At, 0, 1); PG8_STAGE(PG8_SB(0, 0), b2, voffB); PG8_STAGE(PG8_SB(0, 1), b2 + hstep, voffB); PG8_STAGE(PG8_SA(0, 0), a2, voffA); \
            PG8_WAIT_V(8); PG8_WAIT_L(0); PG8_BAR; PG8_MMA(F8, 1, 0, At, B0); PG8_MMA(F8, 1, 1, At, B1); PG8_BAR; PG8_SCHED; \
            PG8_LDB(F8, B0, 1, 0); PG8_LDB(F8, B1, 1, 1); PG8_SCHED; PG8_LDA(F8, At, 1, 0); PG8_STAGE(PG8_SA(0, 1), a2 + hstep, voffA); \
            PG8_WAIT_V(8); PG8_WAIT_L(0); PG8_BAR; PG8_MMA(F8, 0, 0, At, B0); PG8_MMA(F8, 0, 1, At, B1); PG8_BAR; PG8_SCHED; \
            PG8_LDA(F8, At, 1, 1); PG8_STAGE(PG8_SB(1, 0), b3, voffB); PG8_STAGE(PG8_SB(1, 1), b3 + hstep, voffB); PG8_STAGE(PG8_SA(1, 0), a3, voffA); \
            PG8_WAIT_V(8); PG8_WAIT_L(0); PG8_BAR; PG8_MMA(F8, 1, 0, At, B0); PG8_MMA(F8, 1, 1, At, B1); PG8_BAR; PG8_SCHED; }
        static_assert(SP2, "only the two-super-phase K-loop is kept");
        if constexpr (MIX) {
            for (int t = 0; t < Epi::MID_T; t += 2) PG8_ITER(false)
            E.mid(acc, cur, wr, wc, fr, fq);
            for (int t = Epi::MID_T; t < nt; t += 2) PG8_ITER(true)
        } else {
            for (int t = 0; t < nt; t += 2) PG8_ITER(FP8)
        }
        if constexpr (ALIGN_EPI) { if (wr == 0) PG8_BAR; }
        if constexpr (FP8 || MIX) asm volatile("s_nop 15\n\ts_nop 15" ::: "memory");
        E(acc, cur, wr, wc, fr, fq); S.done(cur);
#ifdef PROBE_EPI2
        if (PROBE_EPI2 == 1 || wid == 99) { asm volatile("" ::: "memory"); E(acc, cur, wr, wc, fr, fq); }
        if (PROBE_EPI2 == 2) { asm volatile("" ::: "memory"); E.second(acc, cur, wr, wc, fr, fq); }
#endif
        if (!has_next) break;
        E.init(acc, nxt, wr, wc, fr, fq);
        cur = nxt; cA = nA; cB = nB; ++ui;
        if constexpr (ALIGN_EPI) { if (wr == 1) PG8_BAR; }
    }
    PG8_WAIT_V(0);
    if constexpr (!ALIGN_EPI) { if (wr == 0) PG8_BAR; }
    PG8_BAR;
#undef voffB
#undef PG8_SA
#undef PG8_SB
#undef PG8_STAGE
#undef PG8_LDA
#undef PG8_LDB
#undef PG8_MMA
#undef PG8_MMA8
#undef PG8_ITER
#undef PG8_MMA16_
#undef PG8_LDA8_
#undef PG8_LDA16_
#undef PG8_LDB8_
#undef PG8_LDB16_
#undef PG8_WAIT_V
#undef PG8_WAIT_L
#undef PG8_BAR
#undef PG8_SCHED
}
}

namespace att {
using bf16x8 = __attribute__((ext_vector_type(8))) short;
using s16x4  = __attribute__((ext_vector_type(4))) short;
using f32x16 = __attribute__((ext_vector_type(16))) float;
using f32x4  = __attribute__((ext_vector_type(4))) float;
using u32x4  = __attribute__((ext_vector_type(4))) unsigned;
constexpr int D = 128, NW = 8, QBLK = 32, KVBLK = 64;
constexpr int LDQ = 1024, LDKB = 256, LDOB = 3072;
constexpr size_t SHM_V = KVBLK * D * 2, SHM_K = KVBLK * D * 2, SHM_ATTN = 2 * SHM_V + 2 * SHM_K + NW * 64 * 4;
#define KSWZ(row, colB) ((row) * 256 + ((colB) ^ (((row) & 7) << 4)))
#define SBAR() __builtin_amdgcn_sched_barrier(0)
__device__ __forceinline__ int crow(int r, int hi) { return (r & 3) + 8 * (r >> 2) + 4 * hi; }
__device__ __forceinline__ unsigned cvtpk(float lo, float hi) { unsigned r; asm volatile("v_cvt_pk_bf16_f32 %0, %1, %2" : "=v"(r) : "v"(lo), "v"(hi)); return r; }
__device__ __forceinline__ bf16x8 ld8(const bf16_t* p) { return *reinterpret_cast<const bf16x8*>(p); }

#define PK4(P, BASE, OUT) do { unsigned a0 = cvtpk(P[BASE + 0], P[BASE + 1]), a1 = cvtpk(P[BASE + 2], P[BASE + 3]);   \
    unsigned b0 = cvtpk(P[BASE + 4], P[BASE + 5]), b1 = cvtpk(P[BASE + 6], P[BASE + 7]);                              \
    auto r0 = __builtin_amdgcn_permlane32_swap(a0, b0, false, false); auto r1 = __builtin_amdgcn_permlane32_swap(a1, b1, false, false); \
    u32x4 w = {r0[0], r1[0], r0[1], r1[1]}; OUT = *reinterpret_cast<bf16x8*>(&w); } while (0)
__device__ __forceinline__ void qkt_acc(f32x16& p0, f32x16& p1, const char* Ks, const bf16x8* qr, int ra, int rb, int hi) {
  for (int d0 = 0; d0 < 8; ++d0) { int cb = (d0 * 16 + hi * 8) * 2;
    bf16x8 b0 = *reinterpret_cast<const bf16x8*>(Ks + KSWZ(ra, cb));
    bf16x8 b1 = *reinterpret_cast<const bf16x8*>(Ks + KSWZ(rb, cb));
    p0 = __builtin_amdgcn_mfma_f32_32x32x16_bf16(b0, qr[d0], p0, 0, 0, 0);
    p1 = __builtin_amdgcn_mfma_f32_32x32x16_bf16(b1, qr[d0], p1, 0, 0, 0); }
}
#define KSWZ8(row, ch) ((row) * 128 + ((((ch) ^ (((row) >> 1) & 7))) << 4))
typedef int i32x8 __attribute__((ext_vector_type(8)));
typedef int i32x4 __attribute__((ext_vector_type(4)));
__device__ __forceinline__ i32x8 cat8i(i32x4 a, i32x4 b) { return __builtin_shufflevector(a, b, 0, 1, 2, 3, 4, 5, 6, 7); }
__device__ __forceinline__ void qkt8(f32x16& p0, f32x16& p1, const f32x16& cinit, const char* Ks, const i32x8* q8, int r32, int hi, int sca, int scb) {
  {   const int c0 = 2 * hi;
    const i32x8 a0 = cat8i(*reinterpret_cast<const i32x4*>(Ks + KSWZ8(r32, c0)), *reinterpret_cast<const i32x4*>(Ks + KSWZ8(r32, c0 + 1)));
    const i32x8 a1 = cat8i(*reinterpret_cast<const i32x4*>(Ks + KSWZ8(32 + r32, c0)), *reinterpret_cast<const i32x4*>(Ks + KSWZ8(32 + r32, c0 + 1)));
    p0 = __builtin_amdgcn_mfma_scale_f32_32x32x64_f8f6f4(a0, q8[0], cinit, 0, 0, 0, sca, 0, scb);
    p1 = __builtin_amdgcn_mfma_scale_f32_32x32x64_f8f6f4(a1, q8[0], cinit, 0, 0, 0, sca, 0, scb); }
  {   const int c0 = 2 * hi + 4;
    const i32x8 a0 = cat8i(*reinterpret_cast<const i32x4*>(Ks + KSWZ8(r32, c0)), *reinterpret_cast<const i32x4*>(Ks + KSWZ8(r32, c0 + 1)));
    const i32x8 a1 = cat8i(*reinterpret_cast<const i32x4*>(Ks + KSWZ8(32 + r32, c0)), *reinterpret_cast<const i32x4*>(Ks + KSWZ8(32 + r32, c0 + 1)));
    p0 = __builtin_amdgcn_mfma_scale_f32_32x32x64_f8f6f4(a0, q8[1], p0, 0, 0, 0, sca, 0, scb);
    p1 = __builtin_amdgcn_mfma_scale_f32_32x32x64_f8f6f4(a1, q8[1], p1, 0, 0, 0, sca, 0, scb); }
}
__device__ __forceinline__ int v_st(int k, int c) { const int kk = (k & ~0xC) | ((k & 4) << 1) | ((k & 8) >> 1); return ((kk >> 3) * 4 + (c >> 5)) * 512 + ((kk & 7) * 32 + (c & 31)) * 2; }
__device__ __forceinline__ int v_rd_base(int lane) { return ((lane & 3) << 3) | (((lane >> 2) & 3) << 6) | (((lane >> 4) & 1) << 5) | (((lane >> 5) & 1) << 8); }
constexpr int v_rd_off(int d0, int ks, int half) { return d0 * 512 + ks * 4096 + half * 2048; }
template <int OFF> __device__ __forceinline__ s16x4 tr_read(int vb) {
  s16x4 r; asm volatile("ds_read_b64_tr_b16 %0, %1 offset:%2" : "=&v"(r) : "v"(vb), "i"(OFF) : "memory"); return r;
}
template <int D0> __device__ __forceinline__ void pv_one(f32x16& od, int vb, bf16x8 pa0, bf16x8 pa1, bf16x8 pa2, bf16x8 pa3) {
  const s16x4 l0 = tr_read<v_rd_off(D0, 0, 0)>(vb), h0 = tr_read<v_rd_off(D0, 0, 1)>(vb), l1 = tr_read<v_rd_off(D0, 1, 0)>(vb), h1 = tr_read<v_rd_off(D0, 1, 1)>(vb);
  const s16x4 l2 = tr_read<v_rd_off(D0, 2, 0)>(vb), h2 = tr_read<v_rd_off(D0, 2, 1)>(vb), l3 = tr_read<v_rd_off(D0, 3, 0)>(vb), h3 = tr_read<v_rd_off(D0, 3, 1)>(vb);
  asm volatile("s_waitcnt lgkmcnt(0)" ::: "memory"); SBAR();
#define PK(L, H) (bf16x8){L[0], L[1], L[2], L[3], H[0], H[1], H[2], H[3]}
  od = __builtin_amdgcn_mfma_f32_32x32x16_bf16(pa0, PK(l0, h0), od, 0, 0, 0);
  od = __builtin_amdgcn_mfma_f32_32x32x16_bf16(pa1, PK(l1, h1), od, 0, 0, 0);
  od = __builtin_amdgcn_mfma_f32_32x32x16_bf16(pa2, PK(l2, h2), od, 0, 0, 0);
  od = __builtin_amdgcn_mfma_f32_32x32x16_bf16(pa3, PK(l3, h3), od, 0, 0, 0);
#undef PK
}
__device__ __forceinline__ void pv_d0(f32x16* o, int vb, bf16x8 pa0, bf16x8 pa1, bf16x8 pa2, bf16x8 pa3) {
  pv_one<0>(o[0], vb, pa0, pa1, pa2, pa3); pv_one<1>(o[1], vb, pa0, pa1, pa2, pa3); pv_one<2>(o[2], vb, pa0, pa1, pa2, pa3); pv_one<3>(o[3], vb, pa0, pa1, pa2, pa3);
}
template <int D0> __device__ __forceinline__ void pv_one3(f32x16& od, int vb, bf16x8 pa0, bf16x8 pa1, bf16x8 pa2) {
  const s16x4 l0 = tr_read<v_rd_off(D0, 0, 0)>(vb), h0 = tr_read<v_rd_off(D0, 0, 1)>(vb), l1 = tr_read<v_rd_off(D0, 1, 0)>(vb), h1 = tr_read<v_rd_off(D0, 1, 1)>(vb);
  const s16x4 l2 = tr_read<v_rd_off(D0, 2, 0)>(vb), h2 = tr_read<v_rd_off(D0, 2, 1)>(vb);
  asm volatile("s_waitcnt lgkmcnt(0)" ::: "memory"); SBAR();
#define PK(L, H) (bf16x8){L[0], L[1], L[2], L[3], H[0], H[1], H[2], H[3]}
  od = __builtin_amdgcn_mfma_f32_32x32x16_bf16(pa0, PK(l0, h0), od, 0, 0, 0);
  od = __builtin_amdgcn_mfma_f32_32x32x16_bf16(pa1, PK(l1, h1), od, 0, 0, 0);
  od = __builtin_amdgcn_mfma_f32_32x32x16_bf16(pa2, PK(l2, h2), od, 0, 0, 0);
#undef PK
}
__device__ __forceinline__ void pv_d03(f32x16* o, int vb, bf16x8 pa0, bf16x8 pa1, bf16x8 pa2) {
  pv_one3<0>(o[0], vb, pa0, pa1, pa2); pv_one3<1>(o[1], vb, pa0, pa1, pa2); pv_one3<2>(o[2], vb, pa0, pa1, pa2); pv_one3<3>(o[3], vb, pa0, pa1, pa2);
}
template <bool F8OUT> __device__ __forceinline__ void store_o(const f32x16* o, float l_full, const bf16_t* __restrict__ Zw, unsigned char* __restrict__ Ow, float* li_l, float* ost, int lane, int r32, int hi) {
  asm volatile("" : "+v"(r32), "+v"(hi), "+v"(lane));
  const int rrow = lane >> 3, c8 = (lane & 7) * 8;
  u32x4 zz[2][4];
#pragma unroll
  for (int ps = 0; ps < 2; ++ps)
#pragma unroll
    for (int it = 0; it < 4; ++it) zz[ps][it] = *(const u32x4*)(Zw + (size_t)(8 * it + rrow) * LDQ + ps * 64 + c8);
  if (hi == 0) li_l[r32] = l_full; asm volatile("s_waitcnt lgkmcnt(0)" ::: "memory");
  float rli[16];
#pragma unroll
  for (int r = 0; r < 16; ++r) rli[r] = __builtin_amdgcn_rcpf(li_l[crow(r, hi)]);
  const int r32x = r32 ^ 4, sw = (rrow & 1) << 2;
#pragma unroll
  for (int ps = 0; ps < 2; ++ps) {
#pragma unroll
    for (int r = 0; r < 16; ++r) { const int orow = crow(r, hi), cc = (r & 1) ? r32x : r32;
      ost[orow * 64 + cc] = o[2 * ps][r] * rli[r]; ost[orow * 64 + 32 + cc] = o[2 * ps + 1][r] * rli[r]; }
    asm volatile("s_waitcnt lgkmcnt(0)" ::: "memory");
#pragma unroll
    for (int it = 0; it < 4; ++it) { const int row = 8 * it + rrow;
      const f32x4 v0 = *(const f32x4*)(ost + row * 64 + (c8 ^ sw)), v1 = *(const f32x4*)(ost + row * 64 + ((c8 + 4) ^ sw));
      const u32x4 zq = zz[ps][it];
      const float e0 = v0[0] * __uint_as_float(zq.x << 16), e1 = v0[1] * __uint_as_float(zq.x & 0xffff0000u), e2 = v0[2] * __uint_as_float(zq.y << 16), e3 = v0[3] * __uint_as_float(zq.y & 0xffff0000u);
      const float e4 = v1[0] * __uint_as_float(zq.z << 16), e5 = v1[1] * __uint_as_float(zq.z & 0xffff0000u), e6 = v1[2] * __uint_as_float(zq.w << 16), e7 = v1[3] * __uint_as_float(zq.w & 0xffff0000u);
      if (F8OUT) { unsigned w0 = 0, w1 = 0;
        w0 = __builtin_amdgcn_cvt_pk_fp8_f32(e0 * 64.f, e1 * 64.f, w0, false); w0 = __builtin_amdgcn_cvt_pk_fp8_f32(e2 * 64.f, e3 * 64.f, w0, true);
        w1 = __builtin_amdgcn_cvt_pk_fp8_f32(e4 * 64.f, e5 * 64.f, w1, false); w1 = __builtin_amdgcn_cvt_pk_fp8_f32(e6 * 64.f, e7 * 64.f, w1, true);
        *(unsigned long long*)(Ow + (size_t)row * LDOB + ps * 64 + c8) = (unsigned long long)w0 | ((unsigned long long)w1 << 32); }
      else { u32x4 w; w.x = cvtpk(e0, e1); w.y = cvtpk(e2, e3); w.z = cvtpk(e4, e5); w.w = cvtpk(e6, e7);
        *(u32x4*)(Ow + (size_t)row * LDOB + (ps * 64 + c8) * 2) = w; } }
    asm volatile("s_waitcnt lgkmcnt(0)" ::: "memory");
  }
}

__device__ __forceinline__ void smA(f32x16& p0, f32x16& p1, float negB) {
  for (int r = 0; r < 16; ++r) p0[r] = __builtin_amdgcn_exp2f(p0[r]); for (int r = 0; r < 16; ++r) p1[r] = __builtin_amdgcn_exp2f(p1[r]);
}
__device__ __forceinline__ void smB(f32x16& p0, f32x16& p1, float& l_reg, bf16x8& pa0, bf16x8& pa1, bf16x8& pa2, bf16x8& pa3) {
  float ps = 0; for (int r = 0; r < 16; ++r) ps += p0[r]; for (int r = 0; r < 16; ++r) ps += p1[r];
  l_reg += ps;
  PK4(p0, 0, pa0); PK4(p0, 8, pa1); PK4(p1, 0, pa2); PK4(p1, 8, pa3);
}
__device__ __forceinline__ f32x16 splat16(float v) { f32x16 r; for (int i = 0; i < 16; ++i) r[i] = v; return r; }
__device__ __forceinline__ void gqa_unit(const unsigned char* __restrict__ Qb8, const unsigned char* __restrict__ Kh8, const bf16_t* __restrict__ Vh, const bf16_t* __restrict__ Zb, unsigned char* __restrict__ Ob, int seq, float negB, char* lds) {
  const int tid = threadIdx.x, wid = tid >> 6, lane = tid & 63, r32 = lane & 31, hi = lane >> 5;
  char* V_lds = lds; char* K_lds = lds + 2 * SHM_V;
  float* li_l = (float*)(lds + 2 * SHM_V + 2 * SHM_K) + wid * 64; float* ost = (float*)(lds + SHM_ATTN) + wid * 2048;
  float l_reg = 0; f32x16 o[4] = {}; i32x8 q8[2]; int sca = 0x7c7c7c7c, scb = 0x7f7f7f7f; asm volatile("" : "+v"(sca), "+v"(scb));
  f32x16 cB = splat16(negB); asm volatile("" : "+v"(cB));
  {
    const unsigned char* Qw = Qb8 + (size_t)(wid * QBLK + r32) * 1024 + hi * 32;
#pragma unroll
    for (int s_ = 0; s_ < 2; ++s_) q8[s_] = cat8i(*reinterpret_cast<const i32x4*>(Qw + s_ * 64), *reinterpret_cast<const i32x4*>(Qw + s_ * 64 + 16)); }
  const int vb0 = (int)(uintptr_t)V_lds + v_rd_base(lane);
  typedef __attribute__((address_space(3))) unsigned lds_u32;
  __attribute__((address_space(3))) char* Ll = (__attribute__((address_space(3))) char*)lds;
  const int wu = __builtin_amdgcn_readfirstlane(wid);
  const int krow = tid >> 3; const unsigned koff = (unsigned)krow * 256u + (unsigned)(((tid & 7) ^ ((krow >> 1) & 7)) << 4);
  unsigned voff[2];
#pragma unroll
  for (int i = 0; i < 2; ++i) { const int q = i * 512 + tid, blk = q >> 5, kk = (blk >> 2) * 8 + ((q >> 2) & 7), k = (kk & ~0xC) | ((kk & 4) << 1) | ((kk & 8) >> 1), c = (blk & 3) * 32 + (q & 3) * 8;
    voff[i] = (unsigned)(k * LDKB + c) * 2u; }
#define KDMA(st, k0) __builtin_amdgcn_global_load_lds((const unsigned*)(Kh8 + (size_t)(k0) * 256 + koff), (lds_u32*)(Ll + 2 * SHM_V + (st) * SHM_K + wu * 1024), 16, 0, 0)
#define VDMA(st, k0) do { _Pragma("unroll") for (int i_ = 0; i_ < 2; ++i_) \
    __builtin_amdgcn_global_load_lds((const unsigned*)((const char*)Vh + (size_t)(k0) * (LDKB * 2) + voff[i_]), (lds_u32*)(Ll + (st) * SHM_V + i_ * 8192 + wu * 1024), 16, 0, 0); } while (0)
#define DWAIT() asm volatile("s_waitcnt vmcnt(0)" ::: "memory")
  f32x16 pA0, pA1, pB0, pB1; bf16x8 pa0, pa1, pa2, pa3; const int NT = seq / KVBLK;
  __syncthreads();
  KDMA(0, 0); VDMA(0, 0); KDMA(1, KVBLK); DWAIT(); __syncthreads();
  qkt8(pA0, pA1, cB, K_lds, q8, r32, hi, sca, scb); smA(pA0, pA1, negB);
  __syncthreads();
  for (int j = 0; j + 2 < NT; j += 2) {
    KDMA(0, (j + 2) * KVBLK); VDMA(1, (j + 1) * KVBLK);
    SBAR(); qkt8(pB0, pB1, cB, K_lds + SHM_K, q8, r32, hi, sca, scb);
    smB(pA0, pA1, l_reg, pa0, pa1, pa2, pa3); SBAR();
    pv_d0(o, vb0, pa0, pa1, pa2, pa3); smA(pB0, pB1, negB);
    DWAIT(); __syncthreads();
    if (j + 3 < NT) KDMA(1, (j + 3) * KVBLK);
    VDMA(0, (j + 2) * KVBLK);
    SBAR(); qkt8(pA0, pA1, cB, K_lds, q8, r32, hi, sca, scb);
    smB(pB0, pB1, l_reg, pa0, pa1, pa2, pa3); SBAR();
    pv_d0(o, vb0 + (int)SHM_V, pa0, pa1, pa2, pa3); smA(pA0, pA1, negB);
    DWAIT(); __syncthreads();
  }
  VDMA(1, (NT - 1) * KVBLK);
  SBAR(); qkt8(pB0, pB1, cB, K_lds + SHM_K, q8, r32, hi, sca, scb);
  smB(pA0, pA1, l_reg, pa0, pa1, pa2, pa3); SBAR();
  pv_d0(o, vb0, pa0, pa1, pa2, pa3); smA(pB0, pB1, negB);
  DWAIT(); __syncthreads();
  smB(pB0, pB1, l_reg, pa0, pa1, pa2, pa3); SBAR();
  pv_d0(o, vb0 + (int)SHM_V, pa0, pa1, pa2, pa3);
#undef KDMA
#undef VDMA
#undef DWAIT
  { auto rr = __builtin_amdgcn_permlane32_swap(__float_as_uint(l_reg), __float_as_uint(l_reg), false, false); l_reg = __uint_as_float(rr[0]) + __uint_as_float(rr[1]); }
  {   int t2 = threadIdx.x; asm volatile("" : "+v"(t2));
    const int lane2 = t2 & 63, w2 = __builtin_amdgcn_readfirstlane(t2 >> 6);
    store_o<true>(o, l_reg, Zb + (size_t)(w2 * QBLK) * LDQ, Ob + (size_t)(w2 * QBLK) * LDOB, (float*)(lds + 2 * SHM_V + 2 * SHM_K) + w2 * 64, (float*)(lds + SHM_ATTN) + w2 * 2048, lane2, lane2 & 31, lane2 >> 5); }
}

__device__ __forceinline__ int clampi(int v, int lo, int hi) { return v < lo ? lo : (v > hi ? hi : v); }
__device__ __forceinline__ void na_unit(const bf16_t* __restrict__ Q, const bf16_t* __restrict__ K, const bf16_t* __restrict__ V, const bf16_t* __restrict__ Z, unsigned char* __restrict__ O,
                                        const float* __restrict__ BT, int m0, int s0, int R, int h, char* lds) {
  const int tid = threadIdx.x, wid = __builtin_amdgcn_readfirstlane(tid >> 6), lane = tid & 63, r32 = lane & 31, hi = lane >> 5;
  char* V_lds = lds; char* K_lds = lds + 2 * SHM_V;
  float* li_l = (float*)(lds + 2 * SHM_V + 2 * SHM_K) + wid * 64;
  const int r0 = (m0 - s0) >> 6, r = r0 + (wid >> 1), half = wid & 1;
  const int rs = clampi(r - 4, 0, R - 8), lo = clampi(r0 - 4, 0, R - 8), NT = clampi(r0 - 1, 0, R - 8) + 8 - lo;
  bf16x8 qr[8];
  const bf16_t* Qw = Q + (size_t)(m0 + wid * QBLK + r32) * LDQ + h * D + hi * 8;
#pragma unroll
  for (int d0 = 0; d0 < 8; ++d0) qr[d0] = ld8(Qw + d0 * 16);
  const int ra = r32 + 16 * half, rb = (32 + r32 + 16 * half) & 63;
  const int vb0 = (int)(uintptr_t)V_lds + v_rd_base(lane) + 4096 * half;
  typedef __attribute__((address_space(3))) unsigned lds_u32;
  __attribute__((address_space(3))) char* Ll = (__attribute__((address_space(3))) char*)lds;
  const char* Kg = (const char*)(K + (size_t)(s0 + 64 * lo) * LDQ + h * D); const char* Vg = (const char*)(V + (size_t)(s0 + 64 * lo) * LDQ + h * D);
  unsigned koff[2], voff[2];
#pragma unroll
  for (int i = 0; i < 2; ++i) { const int q = i * 512 + tid;
    { const int row = q >> 4, ch = (q & 15) ^ (row & 7); koff[i] = (unsigned)(row * LDQ + ch * 8) * 2u; }
    { const int blk = q >> 5, kk = (blk >> 2) * 8 + ((q >> 2) & 7), k = (kk & ~0xC) | ((kk & 4) << 1) | ((kk & 8) >> 1), c = (blk & 3) * 32 + (q & 3) * 8; voff[i] = (unsigned)(k * LDQ + c) * 2u; } }
#define NDMA(b, j) do { _Pragma("unroll") for (int i_ = 0; i_ < 2; ++i_) { \
    __builtin_amdgcn_global_load_lds((const unsigned*)(Kg + (size_t)(j) * 131072 + koff[i_]), (lds_u32*)(Ll + 2 * SHM_V + (b) * SHM_K + i_ * 8192 + wid * 1024), 16, 0, 0); \
    __builtin_amdgcn_global_load_lds((const unsigned*)(Vg + (size_t)(j) * 131072 + voff[i_]), (lds_u32*)(Ll + (b) * SHM_V + i_ * 8192 + wid * 1024), 16, 0, 0); } } while (0)
#define DWAIT() asm volatile("s_waitcnt vmcnt(0)" ::: "memory")
  f32x16 o[4] = {}; float l = 0.f;
  float* ost = (float*)(lds + SHM_ATTN) + wid * 2048;
  const int NTp = (NT + 1) & ~1;
  const float* btw = BT + ((size_t)((h * 15) * 2 + half) * 8 * 64 + lane) * 4;
#define ACTIVE(j) ((lo + (j)) >= rs && (lo + (j)) < rs + 8)
#define BLOAD(P0, P1, j) do { if (ACTIVE(j)) { const float* bt = btw + (size_t)(lo + (j) - r + 7) * 4096; \
      _Pragma("unroll") for (int i = 0; i < 4; ++i) { const f32x4 t = *(const f32x4*)(bt + i * 256); P0[4 * i] = t[0]; P0[4 * i + 1] = t[1]; P0[4 * i + 2] = t[2]; P0[4 * i + 3] = t[3]; } \
      _Pragma("unroll") for (int i = 0; i < 2; ++i) { const f32x4 t = *(const f32x4*)(bt + (4 + i) * 256); P1[4 * i] = t[0]; P1[4 * i + 1] = t[1]; P1[4 * i + 2] = t[2]; P1[4 * i + 3] = t[3]; } \
      _Pragma("unroll") for (int i = 8; i < 16; ++i) P1[i] = 0.f; } } while (0)
#define NCOMP(P0, P1, b, nb) do { qkt_acc(P0, P1, K_lds + (b) * SHM_K, qr, ra, rb, hi); \
      _Pragma("unroll") for (int q = 0; q < 16; ++q) P0[q] = __builtin_amdgcn_exp2f(P0[q]); _Pragma("unroll") for (int q = 0; q < 8; ++q) P1[q] = __builtin_amdgcn_exp2f(P1[q]); \
      float ps = 0.f; _Pragma("unroll") for (int q = 0; q < 16; ++q) ps += P0[q]; _Pragma("unroll") for (int q = 0; q < 8; ++q) ps += P1[q]; l += ps; \
      bf16x8 pa0, pa1, pa2; PK4(P0, 0, pa0); PK4(P0, 8, pa1); PK4(P1, 0, pa2); \
      if (nb >= 0) BLOAD(P0, P1, nb); SBAR(); \
      pv_d03(o, vb0 + (b) * (int)SHM_V, pa0, pa1, pa2); } while (0)
  f32x16 pA0 = {}, pA1 = {};
  __syncthreads();
  NDMA(0, 0); BLOAD(pA0, pA1, 0); DWAIT();
  for (int j = 0; j < NTp; j += 2) {
    __syncthreads();
    NDMA(1, j + 1);
    if (ACTIVE(j)) NCOMP(pA0, pA1, 0, j + 1); else BLOAD(pA0, pA1, j + 1);
    DWAIT();
    __syncthreads();
    if (j + 2 < NTp) NDMA(0, j + 2);
    const int nb2 = j + 2 < NTp ? j + 2 : -1;
    if (ACTIVE(j + 1)) NCOMP(pA0, pA1, 1, nb2); else if (nb2 >= 0) BLOAD(pA0, pA1, nb2);
    DWAIT();
  }
  { auto rr = __builtin_amdgcn_permlane32_swap(__float_as_uint(l), __float_as_uint(l), false, false); l = __uint_as_float(rr[0]) + __uint_as_float(rr[1]); }
  store_o<false>(o, l, Z + (size_t)(m0 + wid * QBLK) * LDQ + h * D, O + (size_t)(m0 + wid * QBLK) * LDOB + h * D * 2, li_l, ost, lane, r32, hi);
#undef ACTIVE
#undef BLOAD
#undef NCOMP
#undef NDMA
#undef DWAIT
}
#undef PK4
#undef SBAR
}

constexpr int NWAVES = 8;
constexpr int RING_OFF = 0, RING_BYTES = 131072;
constexpr int XCH_OFF = RING_BYTES, XCH_BYTES = 8192;
constexpr int LDSCTL_OFF = XCH_OFF + XCH_BYTES, MISC_OFF = LDSCTL_OFF + 320;
constexpr int LDS_BYTES = 147456;
static_assert(MISC_OFF + 128 <= LDS_BYTES, "LDS map");
constexpr size_t CTL_ZERO_BYTES = 256 * 1024;
constexpr int CW_BAR = 4096;

#define GAS __attribute__((address_space(1)))
#define LAS __attribute__((address_space(3)))
typedef unsigned v4u __attribute__((ext_vector_type(4)));
typedef float f32x4 __attribute__((ext_vector_type(4)));
typedef GAS unsigned gu32;
#define LDS_WAIT() asm volatile("s_waitcnt lgkmcnt(0)" ::: "memory")
#define VM_WAIT() asm volatile("s_waitcnt vmcnt(0)" ::: "memory")
__device__ __forceinline__ unsigned pk2(float lo, float hi) { return pg8::cvt_pk_bf16(lo, hi); }

#define XB_TMO      128
#define XB_XCNT(j)  (256  + 64 * (j))
#define XB_XSUB(j)  (1280 + 64 * (j))
#define XB_XGEN(j)  (2304 + 64 * (j))
#define XB_TOP      3328
#define XB_TOPGEN   3392
#define XCD_BAR_WORDS 3456
#define XB_SPIN_CAP (1u << 22)
__device__ __forceinline__ unsigned xb_ld(unsigned* p)              { return __hip_atomic_load(p, __ATOMIC_RELAXED, __HIP_MEMORY_SCOPE_AGENT); }
__device__ __forceinline__ unsigned xb_add(unsigned* p, unsigned v) { return __hip_atomic_fetch_add(p, v, __ATOMIC_RELAXED, __HIP_MEMORY_SCOPE_AGENT); }
__device__ __forceinline__ unsigned xb_xcc_id() { return (unsigned)__builtin_amdgcn_s_getreg((3 << 11) | 20) & 0xFu; }
#define XB_SPIN(cond, bar) do { unsigned _sp = 0; while (cond) { __builtin_amdgcn_s_sleep(1); \
    if ((++_sp & 255u) == 0u) { if (xb_ld(&(bar)[XB_TMO])) break; if (_sp > XB_SPIN_CAP) { atomicAdd(&(bar)[XB_TMO], 1u); break; } } } } while (0)
struct XcdBarrier { unsigned* bar; unsigned x; volatile LAS unsigned* st; };
__device__ __forceinline__ XcdBarrier xcd_barrier_post(unsigned* bar, volatile LAS unsigned* st) {
    XcdBarrier b; b.bar = bar; b.x = xb_xcc_id(); b.st = st;
    if (threadIdx.x == 0) (void)xb_add(&bar[XB_XCNT(b.x)], 1u);
    return b;
}
__device__ __forceinline__ void xcd_barrier_complete(unsigned* bar, unsigned x, unsigned& nloc, unsigned& nx) {
    const unsigned G = gridDim.x * gridDim.y * gridDim.z;
    unsigned sum, cnt, mine, sp = 0u;
    for (;;) {
        sum = 0u; cnt = 0u; mine = 0u;
#pragma unroll
        for (unsigned j = 0; j < 16; ++j) { const unsigned c = xb_ld(&bar[XB_XCNT(j)]); sum += c; cnt += (c > 0u) ? 1u : 0u; mine = (j == x) ? c : mine; }
        if (sum == G) break;
        __builtin_amdgcn_s_sleep(1);
        if ((++sp & 255u) == 0u) { if (xb_ld(&bar[XB_TMO])) break; if (sp > XB_SPIN_CAP) { atomicAdd(&bar[XB_TMO], 1u); break; } }
    }
    nloc = mine > 0u ? mine : 1u; nx = cnt > 0u ? cnt : 1u;
}
__device__ __forceinline__ void xcd_barrier(const XcdBarrier& b) {
    asm volatile("s_waitcnt vmcnt(0)" ::: "memory");
    __syncthreads();
    if (threadIdx.x == 0) {
        unsigned* bar = b.bar;
        __builtin_amdgcn_s_waitcnt(0);
        unsigned nloc = b.st[0], nx = b.st[1];
        if (nloc == 0u) { xcd_barrier_complete(bar, b.x, nloc, nx); b.st[0] = nloc; b.st[1] = nx; }
        const unsigned old = xb_add(&bar[XB_XSUB(b.x)], 1u);
        const unsigned gen = old / nloc;
        if (old + 1u == (gen + 1u) * nloc) {
            __builtin_amdgcn_fence(__ATOMIC_RELEASE, "agent");
            asm volatile("s_waitcnt vmcnt(0)" ::: "memory");
            const unsigned og = xb_add(&bar[XB_TOP], 1u);
            const unsigned tg = og / nx;
            if (og + 1u == (tg + 1u) * nx) xb_add(&bar[XB_TOPGEN], 1u);
            else XB_SPIN(xb_ld(&bar[XB_TOPGEN]) == tg, bar);
            __builtin_amdgcn_fence(__ATOMIC_ACQUIRE, "agent");
            xb_add(&bar[XB_XGEN(b.x)], 1u);
            asm volatile("s_waitcnt vmcnt(0)" ::: "memory");
        } else {
            XB_SPIN(xb_ld(&bar[XB_XGEN(b.x)]) == gen, bar);
            __builtin_amdgcn_fence(__ATOMIC_ACQUIRE, "agent");
            asm volatile("s_waitcnt vmcnt(0)" ::: "memory");
        }
    }
    __syncthreads();
}

__device__ __forceinline__ float wave_sum(float v) {
#pragma unroll
    for (int o = 1; o < 64; o <<= 1) v += __shfl_xor(v, o);
    return v;
}
__device__ __forceinline__ float wave_max(float v) {
#pragma unroll
    for (int o = 1; o < 64; o <<= 1) v = fmaxf(v, __shfl_xor(v, o));
    return v;
}
__device__ __forceinline__ int rowmap(int kind, int n) {
    if (kind == 1) { const int cc = n & 31; return (n & ~31) + 16 * ((cc >> 2) & 1) + 4 * (cc >> 3) + (cc & 3); }
    if (kind == 2) { const int d = n & 127; return (n & ~127) + 32 * (2 * (d >> 6) + ((d >> 4) & 1)) + 16 * ((d >> 5) & 1) + 4 * ((d >> 2) & 3) + (d & 3); }
    return n;
}
__device__ __forceinline__ unsigned pk4_fp8(float a, float b, float c, float d) { unsigned w = 0; w = __builtin_amdgcn_cvt_pk_fp8_f32(a, b, w, false); w = __builtin_amdgcn_cvt_pk_fp8_f32(c, d, w, true); return w; }
__device__ __forceinline__ void p0_transpose_item(const float* W, int N, bf16_t* WT, int ldk, int koff, int kind, LAS float* scr, int item, int lane, int row0sel, bool f8) {
    const int nblk = N / 32, kb = item / nblk, nb = item % nblk, k0 = 64 * kb, n0 = 32 * nb;
    const int row0 = row0sel >= 0 ? row0sel : (n0 & ~255);
    float wv[32]; const float* wb = W + (size_t)k0 * N + n0; const unsigned lo_ = (unsigned)(lane >> 5) * (unsigned)N + (unsigned)(lane & 31);
#pragma unroll
    for (int i = 0; i < 32; ++i) wv[i] = __builtin_nontemporal_load(wb + (size_t)(2 * i) * N + lo_);
#pragma unroll
    for (int i = 0; i < 32; ++i) scr[(2 * i + (lane >> 5)) * 33 + (lane & 31)] = wv[i];
    LDS_WAIT(); asm volatile("" ::: "memory");
    const int c = lane & 7;
#pragma unroll
    for (int j = 0; j < 4; ++j) { const int n = (lane >> 3) + 8 * j; const LAS float* s = scr + (8 * c) * 33 + n;
        if (f8) { unsigned long long o8 = (unsigned long long)pk4_fp8(s[0 * 33] * 64.f, s[1 * 33] * 64.f, s[2 * 33] * 64.f, s[3 * 33] * 64.f) | ((unsigned long long)pk4_fp8(s[4 * 33] * 64.f, s[5 * 33] * 64.f, s[6 * 33] * 64.f, s[7 * 33] * 64.f) << 32);
            *(GAS unsigned long long*)((unsigned char*)WT + (size_t)(row0 + rowmap(kind, (n0 & 255) + n)) * ldk + koff + k0 + 8 * c) = o8; }
        else { v4u o; o.x = pk2(s[0 * 33], s[1 * 33]); o.y = pk2(s[2 * 33], s[3 * 33]); o.z = pk2(s[4 * 33], s[5 * 33]); o.w = pk2(s[6 * 33], s[7 * 33]);
            *(GAS v4u*)(WT + (size_t)(row0 + rowmap(kind, (n0 & 255) + n)) * ldk + koff + k0 + 8 * c) = o; } }
    LDS_WAIT(); asm volatile("" ::: "memory");
}
__device__ __forceinline__ void rms_row_to_bf16(const float* xr_, const float* g_, bf16_t* orow, unsigned char* orow8, int lane) {
    const GAS f32x4* xr = (const GAS f32x4*)xr_ + lane; const GAS f32x4* gr = (const GAS f32x4*)g_ + lane;
    f32x4 v[8]; float s = 0.f;
#pragma unroll
    for (int j = 0; j < 8; ++j) { v[j] = __builtin_nontemporal_load(xr + 64 * j); s += (v[j].x * v[j].x + v[j].y * v[j].y) + (v[j].z * v[j].z + v[j].w * v[j].w); }
    const float rstd = 1.0f / sqrtf(wave_sum(s) * (1.f / DM) + EPS);
    GAS unsigned long long* o8 = (GAS unsigned long long*)orow + lane; GAS unsigned* o4 = (GAS unsigned*)orow8 + lane;
#pragma unroll
    for (int j = 0; j < 8; ++j) { const f32x4 g = gr[64 * j]; const float h0 = v[j].x * rstd * g.x, h1 = v[j].y * rstd * g.y, h2 = v[j].z * rstd * g.z, h3 = v[j].w * rstd * g.w;
        o8[64 * j] = (unsigned long long)pk2(h0, h1) | ((unsigned long long)pk2(h2, h3) << 32); o4[64 * j] = pk4_fp8(h0, h1, h2, h3); }
}

template <int NR> __device__ __forceinline__ void rms_load(const Ptrs& P, int m0, int lane, f32x4 (&v)[NR][8]) {
    const GAS f32x4* xr = (const GAS f32x4*)(m0 < MP ? P.xp + (size_t)m0 * DM : P.xs + (size_t)(m0 - MP) * DM) + lane;
#pragma unroll
    for (int r = 0; r < NR; ++r)
#pragma unroll
        for (int j = 0; j < 8; ++j) v[r][j] = __builtin_nontemporal_load(xr + (size_t)r * (DM / 4) + 64 * j);
}
template <int NR, bool GP = false, bool NOST = false> __device__ __forceinline__ void rms_store(const Ptrs& P, int m0, int lane, const f32x4 (&v)[NR][8], const f32x4 (&g_)[8]) {
    unsigned long long ck = 0;
    float rstd[NR];
#pragma unroll
    for (int r = 0; r < NR; ++r) { float s = 0.f;
#pragma unroll
        for (int j = 0; j < 8; ++j) s += (v[r][j].x * v[r][j].x + v[r][j].y * v[r][j].y) + (v[r][j].z * v[r][j].z + v[r][j].w * v[r][j].w);
        rstd[r] = 1.0f / sqrtf(wave_sum(s) * (1.f / DM) + EPS); }
    GAS unsigned long long* o8 = (GAS unsigned long long*)(P.ws + WS_H + (size_t)m0 * DM * 2) + lane; GAS unsigned* o4 = (GAS unsigned*)(P.ws + WS_H8 + (size_t)m0 * DM) + lane;
#pragma unroll
    for (int j = 0; j < 8; ++j) { const f32x4 g = GP ? ((const GAS f32x4*)P.norm_g)[lane + 64 * j] : g_[j];
#pragma unroll
        for (int r = 0; r < NR; ++r) { const float h0 = v[r][j].x * rstd[r] * g.x, h1 = v[r][j].y * rstd[r] * g.y, h2 = v[r][j].z * rstd[r] * g.z, h3 = v[r][j].w * rstd[r] * g.w;
            if (NOST) { ck += ((unsigned long long)pk2(h0, h1) | ((unsigned long long)pk2(h2, h3) << 32)) ^ pk4_fp8(h0, h1, h2, h3); } else {
            o8[(size_t)r * (DM / 4) + 64 * j] = (unsigned long long)pk2(h0, h1) | ((unsigned long long)pk2(h2, h3) << 32); o4[(size_t)r * (DM / 4) + 64 * j] = pk4_fp8(h0, h1, h2, h3); } } }
    if (NOST && ck == 0x123456789abcdefull) o8[0] = ck;
}
__device__ __forceinline__ void rms_gain(const Ptrs& P, int lane, f32x4 (&g)[8]) {
#pragma unroll
    for (int j = 0; j < 8; ++j) g[j] = ((const GAS f32x4*)P.norm_g)[lane + 64 * j];
}
template <int NR>
__device__ __forceinline__ void rms_rows(const Ptrs& P, int m0, int lane) {
    static_assert(NR == 4, "two pairs");
    f32x4 g[8], v[2][8]; rms_gain(P, lane, g);
    rms_load<2>(P, m0, lane, v); rms_store<2>(P, m0, lane, v, g);
    rms_load<2>(P, m0 + 2, lane, v); rms_store<2>(P, m0 + 2, lane, v, g);
}
constexpr int DF_CNT = 40000;
__device__ __forceinline__ int df_row(int g, int q) { return 256 * (12 * (q >> 9) + 2 * g + ((q >> 8) & 1)) + (q & 255); }
struct Args;
__device__ __forceinline__ const Ptrs& df_ptrs();
struct DfOrder {
    pg8::StaticOrder so; bool df;
    __device__ __forceinline__ bool next(int i, pg8::Unit& u) const {
        pg8::Unit t; t.pm = 0; t.pn = 0; const bool ok0 = so.next(i, t);
        const int xcd = blockIdx.x & 7, j = blockIdx.x >> 3;
        u.pm = df ? 12 * xcd + 2 * i + (j & 1) : t.pm; u.pn = df ? (j >> 1) : t.pn; u.ri = i;
        return df ? (i < 6) : ok0;
    }
    __device__ __forceinline__ void a_ready(const pg8::Unit&) const {}
    static __device__ __forceinline__ void produce(int g) {
        const Ptrs& P = df_ptrs();
        const int tid = threadIdx.x, lane = tid & 63, wave = __builtin_amdgcn_readfirstlane(tid >> 6), xcd = blockIdx.x & 7, j = blockIdx.x >> 3;
#ifdef PROBE_T
        if (tid == 0 && g == 3) ((unsigned long long*)(P.ws + WS_CTL + 800 * 1024))[64 + blockIdx.x * 16 + 13] = __builtin_amdgcn_s_memrealtime();
#endif
        const int q0 = ((xcd * 8 + (j & 7)) * 8 + wave) * 8;
        const int m0 = df_row(g, q0);
        f32x4 gn[8], va[2][8], vb[2][8]; rms_gain(P, lane, gn);
#ifdef PROBE_RD
        if (g == 3) { const int md = df_row(5, q0);
            rms_load<2>(P, md, lane, va); rms_load<2>(P, md + 2, lane, vb);
            rms_store<2, false, true>(P, md, lane, va, gn); rms_load<2>(P, md + 4, lane, va);
            rms_store<2, false, true>(P, md + 2, lane, vb, gn); rms_load<2>(P, md + 6, lane, vb);
            rms_store<2, false, true>(P, md + 4, lane, va, gn); rms_store<2, false, true>(P, md + 6, lane, vb, gn);
        }
#endif
        rms_load<2>(P, m0, lane, va); rms_load<2>(P, m0 + 2, lane, vb);
        rms_store<2>(P, m0, lane, va, gn); rms_load<2>(P, m0 + 4, lane, va);
        rms_store<2>(P, m0 + 2, lane, vb, gn); rms_load<2>(P, m0 + 6, lane, vb);
        rms_store<2>(P, m0 + 4, lane, va, gn); rms_store<2>(P, m0 + 6, lane, vb, gn);
        asm volatile("s_waitcnt vmcnt(0)" ::: "memory");
        __builtin_amdgcn_s_barrier();
#ifdef PROBE_T
        if (tid == 0 && g == 3) ((unsigned long long*)(P.ws + WS_CTL + 800 * 1024))[64 + blockIdx.x * 16 + 12] = __builtin_amdgcn_s_memrealtime();
#endif
        if (tid == 0) { __builtin_amdgcn_fence(__ATOMIC_RELEASE, "agent"); (void)xb_add((unsigned*)(P.ws + WS_CTL) + DF_CNT + 64 * g, 1u); }
    }
    static __device__ __forceinline__ void wait(int g) {
        if (threadIdx.x == 0) { unsigned* c = (unsigned*)(df_ptrs().ws + WS_CTL) + DF_CNT + 64 * g; unsigned sp = 0; while (xb_ld(c) < 64u) { __builtin_amdgcn_s_sleep(1); if (++sp > XB_SPIN_CAP) break; } }
        asm volatile("" ::: "memory");
        __builtin_amdgcn_s_barrier();
        asm volatile("" ::: "memory");
    }
    __device__ __forceinline__ void done(const pg8::Unit& u) const {
        if (!df) return;
        const int i = u.ri, j8 = blockIdx.x >> 6;
        if (DF_MODE == 0 && i <= 2 && j8 == i + 1) produce(i + 3);
        if (DF_MODE == 0 && i <= 3) wait(i + 2);
    }
};

#ifdef PROBE_T
__device__ int g_probe[3] = {PROBE_A, PROBE_B, PROBE_MODE};
__device__ float g_pscale = PROBE_SCALE;
#endif
struct Args { Ptrs P; int ph_lo, ph_hi, li, pad; };
__device__ __forceinline__ const Ptrs& df_ptrs() {
    const __attribute__((address_space(4))) Args* ka = (const __attribute__((address_space(4))) Args*)__builtin_amdgcn_kernarg_segment_ptr();
    asm volatile("" : "+s"(ka));
    return *(const Ptrs*)&((const Args*)ka)->P;
}
__global__ void __launch_bounds__(NWAVES * 64, 2) mega(Args args) {
    extern __shared__ __attribute__((aligned(16))) unsigned char lds[];
    LAS unsigned char* L = (LAS unsigned char*)lds;
    volatile LAS unsigned* MISC = (volatile LAS unsigned*)(L + MISC_OFF);
    const int tid = threadIdx.x, lane = tid & 63, wave = __builtin_amdgcn_readfirstlane(tid >> 6);
    const int G = gridDim.x; const int bx = blockIdx.x; const int vcu = (G % 8 == 0) ? (bx % 8) * (G / 8) + bx / 8 : bx;
    const Ptrs& P = args.P; unsigned char* ws = P.ws;
    gu32* ctl = (gu32*)(ws + WS_CTL);
    for (int u = tid; u < (LDS_BYTES - LDSCTL_OFF) / 4; u += NWAVES * 64) ((LAS unsigned*)(L + LDSCTL_OFF))[u] = 0u;
    __syncthreads();
    const int lo = args.ph_lo, hi = args.ph_hi;
    XcdBarrier bar; bar.bar = (unsigned*)(ctl + CW_BAR) + args.li * XCD_BAR_WORDS; bar.x = 0; bar.st = nullptr;
    if (hi - lo > 1) bar = xcd_barrier_post((unsigned*)(ctl + CW_BAR) + args.li * XCD_BAR_WORDS, MISC + 8);
#ifndef PH_ENABLE
#define PH_ENABLE 63
#endif
#ifndef REPEAT_MASK
#define REPEAT_MASK 0
#endif
#if REPEAT_MASK
#define REP(k) for (int rep_ = 0; rep_ < 1 + ((REPEAT_MASK >> (k)) & 1); ++rep_)
#else
#define REP(k)
#endif
#define IN(k) (((PH_ENABLE >> (k)) & 1) && lo <= (k) && (k) < hi)
#ifdef PROBE_T
    unsigned long long* TS = (unsigned long long*)(ws + WS_CTL + 800 * 1024);
#ifndef PROBE_BX
#define PROBE_BX 0
#endif
#define STAMP(k) do { if (tid == 0) { const unsigned long long t_ = __builtin_amdgcn_s_memrealtime(); TS[64 + bx * 16 + (k)] = t_; if (bx == PROBE_BX) { TS[k] = t_; TS[32 + (k)] = __builtin_amdgcn_s_memtime(); } } } while (0)
#else
#define STAMP(k)
#endif
    STAMP(0);
    const bool df = (G == 256) && IN(0) && IN(1);
    bf16_t* Hb = (bf16_t*)(ws + WS_H); bf16_t* WinT = (bf16_t*)(ws + WS_WIN); bf16_t* WabT = (bf16_t*)(ws + WS_WAB); bf16_t* WoT = (bf16_t*)(ws + WS_WO);

    if (IN(0)) {
        REP(0) {
        LAS float* scr = (LAS float*)(L + RING_OFF + wave * 16384);
        const int gw = vcu * NWAVES + wave, NGW = G * NWAVES;
        constexpr int I_IN = (DM / 64) * (NIN / 32), I_AB = (1024 / 64) * (DM / 32), I_O = (DM / 64) * (DM / 32);
        constexpr int NITEMS = I_IN + 2 * I_AB + I_O;
        for (int it = gw; it < (df ? I_IN : NITEMS); it += NGW) {
            int r = it;
            if (r < I_IN) { const int n0 = 32 * (r % (NIN / 32)), pn = n0 >> 8; const bool f8 = pg8::pn_is8(pn);
                p0_transpose_item(P.w_in, NIN, f8 ? (bf16_t*)(ws + WS_WIN8) : WinT, DM, 0,     (n0 >= C_GQQ && n0 < C_GQV) ? 2 : 1, scr, r, lane, pg8::pn_idx(pn) * 256, f8); continue; } r -= I_IN;
            if (r < I_AB) { p0_transpose_item(P.w_a, DM, WabT, 1536, 0, 1, scr, r, lane, -1, false); continue; } r -= I_AB;
            if (r < I_AB) { p0_transpose_item(P.w_b, DM, WabT, 3072, 2048, 1, scr, r, lane, -1, true); continue; } r -= I_AB;
            p0_transpose_item(P.w_out, DM, WoT, DM, 0, 0, scr, r, lane, -1, false);
        }
        if (df && DF_MODE == 0) { for (int q = 4 * gw; q < 8192; q += 4 * NGW) rms_rows<4>(P, df_row(q >> 12, q & 4095), lane); }
        else for (int m = 4 * gw; m < M; m += 4 * NGW) rms_rows<4>(P, m, lane);
        const int gt = vcu * (NWAVES * 64) + tid, NGT = G * NWAVES * 64;
        for (int i = gt; i < 128 * 32; i += NGT) { const int pos = i >> 5, f = i & 31; const float ang = (float)pos * powf(10000.0f, -(float)(2 * f) / 64.0f);
            float* T = (float*)(ws + WS_ROPE); T[i] = cosf(ang); T[4096 + i] = sinf(ang); }
        if (gt < 64) {
            const float gq = wave_max(fmaxf(fabsf(P.gq_q_g[lane]), fabsf(P.gq_q_g[lane + 64]))), gk = wave_max(fmaxf(fabsf(P.gq_k_g[lane]), fabsf(P.gq_k_g[lane + 64])));
            if (lane == 0) ((float*)(ws + WS_ROPE))[8192] = -(QSCALE * 128.0f * gq * gk);
        }
        {
            const float gq = wave_max(fmaxf(fabsf(P.na_q_g[lane]), fabsf(P.na_q_g[lane + 64]))), gk = wave_max(fmaxf(fabsf(P.na_k_g[lane]), fabsf(P.na_k_g[lane + 64])));
            const float Bna = QSCALE * 128.0f * gq * gk;
            f32x4* BT = (f32x4*)(ws + WS_BIAS);
            for (int e = gt; e < 8 * 15 * 2 * 8 * 64; e += NGT) {
                const int ln = e & 63, i = (e >> 6) & 7, half = (e >> 9) & 1, hd = e >> 10;
                const int c = 32 * half + (ln & 31), kc0 = (32 * (i >> 2) + 8 * (i & 3) + 4 * (ln >> 5) + 16 * half) & 63;
                int cs = c - 8; cs = cs < 0 ? 0 : (cs > 48 ? 48 : cs);
                f32x4 v;
#pragma unroll
                for (int q = 0; q < 4; ++q) { const int kc = kc0 + q; const bool valid = (kc >= cs) && (kc < cs + 16); const int idx = valid ? (kc - c + 15) : 15;
                    const float b = P.na_rpb[hd * 31 + idx] * LOG2E - Bna; v[q] = valid ? b : -30000.0f; }
                BT[e] = v;
            }
        }
        }
        STAMP(1);
        if (IN(1)) xcd_barrier(bar);
        STAMP(2);
    }
    if (IN(1)) {
        {   pg8::Gemm g{Hb, WinT, M, pg8::N16 * 256, DM}; DfOrder S; S.so.init(M, pg8::N16 * 256, G, bx); S.df = df;
            pg8::EpiA<false> E{P, (LAS float*)(L + XCH_OFF)};
            STAMP(10); STAMP(13); STAMP(12); if (DF_MODE == 0 && df && (bx >> 6) == 0) DfOrder::produce(2); STAMP(11);
            REP(1) pg8::gemm_phase<pg8::EpiA<false>, DfOrder, true, true, false>(L + RING_OFF, g, S, E); }
        {   pg8::Gemm g{(const bf16_t*)(ws + WS_H8), (const bf16_t*)(ws + WS_WIN8), M, pg8::N8 * 256, DM / 2}; pg8::StaticOrder S; S.init(M, pg8::N8 * 256, G, bx);
            pg8::EpiA<true> E{P, (LAS float*)(L + XCH_OFF)};
            REP(1) pg8::gemm_phase<pg8::EpiA<true>, pg8::StaticOrder, true, true, true>(L + RING_OFF, g, S, E); }
        if (df && bx >= 192) {
            LAS float* scr = (LAS float*)(L + RING_OFF + wave * 16384);
            constexpr int I_AB = (1024 / 64) * (DM / 32), I_O = (DM / 64) * (DM / 32);
            for (int r0 = (bx - 192) * NWAVES + wave; r0 < 2 * I_AB + I_O; r0 += 64 * NWAVES) { int r = r0;
                if (r < I_AB) { p0_transpose_item(P.w_a, DM, WabT, 1536, 0, 1, scr, r, lane, -1, false); continue; } r -= I_AB;
                if (r < I_AB) { p0_transpose_item(P.w_b, DM, WabT, 3072, 2048, 1, scr, r, lane, -1, true); continue; } r -= I_AB;
                p0_transpose_item(P.w_out, DM, WoT, DM, 0, 0, scr, r, lane, -1, false); }
        }
        STAMP(3);
        if (IN(2) || IN(3)) xcd_barrier(bar);
        STAMP(4);
    }
    if ((IN(2) || IN(3)) && wave >= 4) __builtin_amdgcn_s_setprio(1);
    if (IN(2)) {
        const bf16_t* QB = (const bf16_t*)(ws + WS_QB); const bf16_t* KB = (const bf16_t*)(ws + WS_KB); const bf16_t* VB = (const bf16_t*)(ws + WS_VB); const bf16_t* ZB = (const bf16_t*)(ws + WS_ZB);
        unsigned char* OB = ws + WS_OAB + 2048;
        const float negB = ((const float*)(ws + WS_ROPE))[8192];
        REP(2)
        for (int u = vcu; u < 768; u += G) {
            int h, seq; size_t t0, m0;
            if (u < 256) { h = u >> 5; t0 = 0; m0 = (size_t)(u & 31) * 256; seq = 8192; }
            else { const int s = u - 256; h = (s >> 3) & 7; t0 = (size_t)MP + (size_t)(s >> 6) * 2048; m0 = t0 + (size_t)(s & 7) * 256; seq = 2048; }
            att::gqa_unit((const unsigned char*)QB + m0 * 1024 + h * 128, (const unsigned char*)KB + t0 * 256 + (h >> 2) * 128, VB + t0 * 256 + (h >> 2) * 128, ZB + m0 * 1024 + h * 128, OB + m0 * 3072 + h * 128, seq, negB, (char*)lds);
        }
    }
    STAMP(5);
    if (IN(3)) {
        const bf16_t* QA = (const bf16_t*)(ws + WS_QA); const bf16_t* KA = (const bf16_t*)(ws + WS_KA); const bf16_t* VA = (const bf16_t*)(ws + WS_VA); const bf16_t* ZA = (const bf16_t*)(ws + WS_ZA);
        unsigned char* OA = ws + WS_OAB;
        REP(3)
        for (int n = vcu; n < 768; n += G) { const int h = (n >> 5) & 7, tb = (n >> 8) * 32 + (n & 31), m0 = tb * 256;
            const int s0 = m0 < MP ? 0 : MP + (((m0 - MP) >> 11) << 11), R = m0 < MP ? 128 : 32;
            att::na_unit(QA, KA, VA, ZA, OA, (const float*)(ws + WS_BIAS), m0, s0, R, h, (char*)lds); }
        __syncthreads();
    }
    __builtin_amdgcn_s_setprio(0);
    STAMP(6);
    if ((IN(2) || IN(3)) && IN(4)) xcd_barrier(bar);
    STAMP(7);
    if (IN(4)) {
        pg8::Gemm g{(const bf16_t*)(ws + WS_OAB), WabT, M, DM, 1536}; pg8::StaticOrder S; S.init(M, DM, G, bx);
        pg8::EpiC1 E{(const bf16_t*)P.out, (const unsigned char*)P.out + (size_t)M * DM * 2, (bf16_t*)(ws + WS_MG)};
        REP(4) pg8::gemm_phase<pg8::EpiC1, pg8::StaticOrder, true, true, false, true>(L + RING_OFF, g, S, E);
        STAMP(8);
        if (IN(5)) xcd_barrier(bar);
#ifdef DOUBLE_BAR
        if (IN(5)) { for (int q_ = 0; q_ < DOUBLE_BAR; ++q_) xcd_barrier(bar); }
#endif
        STAMP(9);
    }
    if (IN(5)) {
        pg8::Gemm g{(const bf16_t*)(ws + WS_MG), WoT, M, DM, DM}; pg8::StaticOrder S; S.init(M, DM, G, bx);
#ifdef PROBE_T
        float pscale = 1.0f;
        {   const int ka = g_probe[0], kb = g_probe[1], mode = g_probe[2];
            if (mode == 0) pscale = 1.0f + (float)(TS[64 + ka] - TS[64 + kb]) * g_pscale;
            else if (mode == 1 || mode == 2) { unsigned long long acc_ = mode == 1 ? 0ull : ~0ull;
                for (int b = 0; b < G; ++b) { const unsigned long long d = TS[64 + b * 16 + ka] - TS[64 + b * 16 + kb]; acc_ = mode == 1 ? (d > acc_ ? d : acc_) : (d < acc_ ? d : acc_); }
                pscale = 1.0f + (float)acc_ * g_pscale; }
            else if (mode == 4) pscale = 1.0f + (float)(TS[32 + 3] - TS[32 + 2]) / (float)(TS[3] - TS[2]) * 1e-3f; }
        pg8::EpiC2 E{P.xp, P.xs, P.out, pscale};
#else
        pg8::EpiC2 E{P.xp, P.xs, P.out, 1.0f};
#endif
        REP(5) pg8::gemm_phase<pg8::EpiC2, pg8::StaticOrder, true, true>(L + RING_OFF, g, S, E);
#if defined(PROBE_T)
        if (bx == 0 && g_probe[2] == 3) {
            __syncthreads();
            if (tid == 0) TS[64 + 10] = __builtin_amdgcn_s_memrealtime();
            asm volatile("s_waitcnt vmcnt(0)" ::: "memory"); __syncthreads();
            const float sc2 = 1.0f + (float)(TS[64 + g_probe[0]] - TS[64 + g_probe[1]]) * g_pscale;
            pg8::Unit lu; int nu = 0; while (S.next(nu, lu)) ++nu; S.next(nu - 1, lu);
            for (int e = tid; e < 256 * 256; e += NWAVES * 64) { float* p = P.out + (size_t)(lu.pm * 256 + (e >> 8)) * DM + lu.pn * 256 + (e & 255); *p = *p * sc2; }
        }
#endif
    }
#undef IN
}

extern "C" void kernel_launch(void* const* d_in, const int* in_sizes, int n_in, void* d_out, int out_size, void* d_ws, size_t ws_size, hipStream_t stream) {
    static int grid = 0;
    if (grid == 0) {
        if (n_in != 13 || in_sizes[0] != MP * DM || in_sizes[1] != MS * DM || in_sizes[3] != DM * NIN || out_size != M * DM || ws_size < WS_END) {
            fprintf(stderr, "kernel_launch: shape mismatch n_in %d out %d ws %zu (need %zu)\n", n_in, out_size, ws_size, (size_t)WS_END); grid = -1; return; }
        int dev = 0, cus = 0, per_cu = 0;
        if (hipGetDevice(&dev) != hipSuccess || hipDeviceGetAttribute(&cus, hipDeviceAttributeMultiprocessorCount, dev) != hipSuccess) { fprintf(stderr, "kernel_launch: device query failed\n"); grid = -1; return; }
        if (hipFuncSetAttribute((const void*)mega, hipFuncAttributeMaxDynamicSharedMemorySize, LDS_BYTES) != hipSuccess) { fprintf(stderr, "kernel_launch: hipFuncSetAttribute failed\n"); grid = -1; return; }
        if (hipOccupancyMaxActiveBlocksPerMultiprocessor(&per_cu, (const void*)mega, NWAVES * 64, LDS_BYTES) != hipSuccess || per_cu < 1) { fprintf(stderr, "kernel_launch: occupancy query says %d blocks per CU\n", per_cu); }
        (void)hipGetLastError();
        grid = cus;
    }
    if (grid < 0) return;
    Ptrs P{};
    P.xp = (const float*)d_in[0]; P.xs = (const float*)d_in[1]; P.norm_g = (const float*)d_in[2]; P.w_in = (const float*)d_in[3];
    P.na_q_g = (const float*)d_in[4]; P.na_k_g = (const float*)d_in[5]; P.na_rpb = (const float*)d_in[6]; P.gq_q_g = (const float*)d_in[7]; P.gq_k_g = (const float*)d_in[8];
    P.w_a = (const float*)d_in[9]; P.w_b = (const float*)d_in[10]; P.gate_bias = (const float*)d_in[11]; P.w_out = (const float*)d_in[12];
    P.out = (float*)d_out; P.ws = (unsigned char*)d_ws;
    (void)hipMemsetAsync((char*)d_ws + WS_CTL, 0, CTL_ZERO_BYTES, stream);
    Args a{}; a.P = P; a.ph_lo = 0; a.ph_hi = 6; a.li = 0;
    hipLaunchKernelGGL(mega, dim3(grid), dim3(NWAVES * 64), LDS_BYTES, stream, a);
    const hipError_t le = hipPeekAtLastError();
    if (le != hipSuccess) fprintf(stderr, "kernel_launch: launch failed: %s\n", hipGetErrorName(le));
}
```

```cpp
#include <hip/hip_runtime.h>
#include <cstdio>
#include <cstdint>

constexpr int DM = 2048, MP = 8192, MS = 16384, M = MP + MS;
constexpr int NIN = 10752;
constexpr int C_NAQ = 0, C_NAK = 1024, C_NAV = 2048, C_NAZ = 3072, C_GQQ = 4096, C_GQK = 5120, C_GQV = 5376, C_GQZ = 5632, C_GA = 6656, C_GB = 8704;
constexpr float EPS = 1e-6f;
constexpr float QSCALE = 0.08838834764831845f * 1.4426950408889634f;
constexpr float LOG2E = 1.4426950408889634f;

typedef unsigned short bf16_t;
__device__ __forceinline__ float bf2f(bf16_t b) { return __uint_as_float(((unsigned)b) << 16); }
__device__ __forceinline__ bf16_t f2bf(float f) { unsigned u = __float_as_uint(f); u += 0x7fffu + ((u >> 16) & 1u); return (bf16_t)(u >> 16); }

constexpr size_t MiB = 1u << 20;
constexpr size_t WS_CTL = 0;
constexpr size_t WS_ROPE = 1 * MiB;
constexpr size_t WS_BIAS = 1 * MiB + 64 * 1024;
constexpr size_t WS_WIN = 3 * MiB;
constexpr size_t WS_WIN8 = 27 * MiB;
constexpr size_t WS_WAB = 40 * MiB, WS_WO = 48 * MiB;
constexpr size_t WS_H8 = 56 * MiB;
constexpr size_t WS_H = 104 * MiB;
constexpr size_t WS_OAB = WS_H;
constexpr size_t WS_QA = 200 * MiB, WS_KA = 248 * MiB, WS_VA = 296 * MiB, WS_ZA = 344 * MiB;
constexpr size_t WS_QB = 392 * MiB, WS_ZB = 440 * MiB;
constexpr size_t WS_KB = 488 * MiB, WS_VB = 500 * MiB;
constexpr size_t WS_MG = WS_QA;
constexpr size_t WS_END = 512 * MiB;

struct Ptrs {
    const float *xp, *xs, *norm_g, *w_in, *na_q_g, *na_k_g, *na_rpb, *gq_q_g, *gq_k_g, *w_a, *w_b, *gate_bias, *w_out;
    float* out; unsigned char* ws;
};
__device__ __forceinline__ const float* xrow(const Ptrs& P, int m) { return m < MP ? P.xp + (size_t)m * DM : P.xs + (size_t)(m - MP) * DM; }
__device__ __forceinline__ int seq_start(int m) { return m < MP ? 0 : MP + ((m - MP) >> 11 << 11); }
__device__ __forceinline__ int seq_rows(int m) { return m < MP ? 128 : 32; }

#ifndef DF_MODE
#define DF_MODE 0
#endif
namespace pg8 {
#define PG8_LAS __attribute__((address_space(3)))
typedef short bf16x8 __attribute__((ext_vector_type(8)));
typedef float f32x4 __attribute__((ext_vector_type(4)));
typedef unsigned u32x4 __attribute__((ext_vector_type(4)));
typedef unsigned u32x2 __attribute__((ext_vector_type(2)));
typedef float f32x2 __attribute__((ext_vector_type(2)));
constexpr int BM = 256, BK = 64, HALF = 128, HTB = HALF * BK * 2, STAGE_BYTES = 8 * HTB, NXCD = 8, WGM = 8;

__host__ __device__ __forceinline__ int lds_byte(int r, int c) { const int st = (r >> 4) * 2 + (c >> 5), rr = r & 15, cc = c & 31, ob = rr * 64 + cc * 2; return st * 1024 + (ob ^ (((ob >> 9) & 1) << 5)); }
__host__ __device__ __forceinline__ void stage_rc(int b, int& R, int& C) { const int st = b / 1024, sb = b % 1024, swz = sb ^ (((sb >> 9) & 1) << 5); R = (st >> 1) * 16 + swz / 64; C = (st & 1) * 32 + (swz % 64) / 2; }

struct Unit { int pm, pn, ri; };
struct Gemm { const bf16_t* A; const bf16_t* Bt; int M, N, K; };

struct StaticOrder {
    int nM, nN, nwg, G, c;
    __host__ __device__ void init(int M_, int N_, int G_, int c_) { nM = M_ / BM; nN = N_ / BM; nwg = nM * nN; G = G_; c = c_; }
    __host__ __device__ bool next(int i, Unit& u) const {
        const long L = (long)i * G + c; if (L >= nwg) return false;
        int wgid = (int)L; { const int q = nwg / NXCD, r = nwg % NXCD, xcd = wgid % NXCD, off = wgid / NXCD; wgid = (xcd < r ? xcd * (q + 1) : r * (q + 1) + (xcd - r) * q) + off; }
        const int nig = WGM * nN, gid = wgid / nig, fm = gid * WGM, gsz = (nM - fm) < WGM ? (nM - fm) : WGM;
        u.pm = fm + ((wgid % nig) % gsz); u.pn = (wgid % nig) / gsz; return true;
    }
    __device__ __forceinline__ void a_ready(const Unit&) const {}
    __device__ __forceinline__ void done(const Unit&) const {}
};

__device__ __forceinline__ unsigned cvt_pk_bf16(float lo, float hi) { unsigned r; asm volatile("v_cvt_pk_bf16_f32 %0, %1, %2" : "=v"(r) : "v"(lo), "v"(hi)); return r; }
__device__ __forceinline__ float bflo(unsigned w) { return __uint_as_float(w << 16); }
__device__ __forceinline__ float bfhi(unsigned w) { return __uint_as_float(w & 0xffff0000u); }
__device__ __forceinline__ float sigm(float v) { return __builtin_amdgcn_rcpf(1.0f + __builtin_amdgcn_exp2f(-v * LOG2E)); }

__device__ __forceinline__ void acc_zero(f32x4 (&acc)[2][2][4][2]) {
#pragma unroll
    for (int a = 0; a < 2; ++a)
#pragma unroll
        for (int b = 0; b < 2; ++b)
#pragma unroll
            for (int m = 0; m < 4; ++m)
#pragma unroll
                for (int n = 0; n < 2; ++n) acc[a][b][m][n] = (f32x4){0.f, 0.f, 0.f, 0.f};
}
enum { T_PLAIN = 0, T_SILU = 1, T_GATE = 2, T_NORM = 3, T_ROPE = 4 };
#ifndef FP8_GA
#define FP8_GA 1
#endif
constexpr int N16 = FP8_GA ? 16 : 24, N8 = 42 - N16;
__host__ __device__ __forceinline__ int pn_of16(int i) { return i < 16 ? i : 26 + (i - 16); }
__host__ __device__ __forceinline__ int pn_of8(int i) { return i < 10 ? 16 + i : (FP8_GA ? 26 + (i - 10) : 34 + (i - 10)); }
__host__ __device__ __forceinline__ bool pn_is8(int pn) { return (pn >= 16 && pn < 26) || pn >= 34 || (FP8_GA && pn >= 26); }
__host__ __device__ __forceinline__ int pn_idx(int pn) { return pn < 16 ? pn : (pn < 26 ? pn - 16 : (pn < 34 ? (FP8_GA ? 10 + pn - 26 : 16 + pn - 26) : (FP8_GA ? 10 + pn - 26 : 10 + pn - 34))); }
template <bool IS8> struct EpiA {
    static constexpr bool PERM = false, AFTER_DRAIN = false, HAS_MID = false; static constexpr int MID_T = 1 << 30;
    Ptrs P; PG8_LAS float* X;
    __device__ __forceinline__ void mid(f32x4 (&)[2][2][4][2], const Unit&, int, int, int, int) const {}
    __device__ __forceinline__ void second(f32x4 (&)[2][2][4][2], const Unit&, int, int, int, int) const {}
    __device__ __forceinline__ void init(f32x4 (&acc)[2][2][4][2], const Unit&, int, int, int, int) const { acc_zero(acc); }
    __device__ __forceinline__ void operator()(f32x4 (&acc)[2][2][4][2], const Unit& u, int wr, int wc, int fr, int fq) const {
        asm volatile("" : "+v"(fr), "+v"(fq));
        const int pn = IS8 ? pn_of8(u.pn) : pn_of16(u.pn); unsigned char* ws = P.ws;
        int type, ldc = 1024, coff; bf16_t* dst; const float* gw = P.na_q_g; float gs = 1.f; const float* bias = P.gate_bias;
        if (!IS8 && pn < 4)        { type = T_NORM;  dst = (bf16_t*)(ws + WS_QA); coff = pn * 256; gw = P.na_q_g; gs = QSCALE; }
        else if (!IS8 && pn < 8)   { type = T_NORM;  dst = (bf16_t*)(ws + WS_KA); coff = (pn - 4) * 256; gw = P.na_k_g; }
        else if (!IS8 && pn < 12)  { type = T_PLAIN; dst = (bf16_t*)(ws + WS_VA); coff = (pn - 8) * 256; }
        else if (!IS8 && pn < 16)  { type = T_SILU;  dst = (bf16_t*)(ws + WS_ZA); coff = (pn - 12) * 256; }
        else if (IS8 && pn < 20)  { type = T_ROPE;  dst = (bf16_t*)(ws + WS_QB); coff = (pn - 16) * 256; gw = P.gq_q_g; gs = QSCALE * 8.0f; }
        else if (IS8 && pn == 20) { type = T_ROPE;  dst = (bf16_t*)(ws + WS_KB); coff = 0; ldc = 256; gw = P.gq_k_g; }
        else if (IS8 && pn == 21) { type = T_PLAIN; dst = (bf16_t*)(ws + WS_VB); coff = 0; ldc = 256; }
        else if (IS8 && pn < 26)  { type = T_SILU;  dst = (bf16_t*)(ws + WS_ZB); coff = (pn - 22) * 256; }
        else if (pn < 34)  { type = T_GATE;  dst = (bf16_t*)P.out; coff = (pn - 26) * 256; ldc = 2048; bias = P.gate_bias + coff; }
        else               { type = T_GATE;  dst = (bf16_t*)P.out + (size_t)M * DM; coff = (pn - 34) * 256; ldc = 2048; bias = P.gate_bias + 2048 + coff; }
        const int row0 = u.pm * BM + wr * 64 + fr, c8 = wc * 32 + 8 * fq;
        if (type <= T_GATE) {
            f32x4 bv[2][2];
#pragma unroll
            for (int bj = 0; bj < 2; ++bj)
#pragma unroll
                for (int n = 0; n < 2; ++n) bv[bj][n] = (type == T_GATE) ? *(const f32x4*)(bias + bj * HALF + c8 + 4 * n) : (f32x4){0.f, 0.f, 0.f, 0.f};
            if (type == T_GATE && pn >= 34) {
#pragma unroll
                for (int ai = 0; ai < 2; ++ai)
#pragma unroll
                    for (int bj = 0; bj < 2; ++bj)
#pragma unroll
                        for (int mp = 0; mp < 2; ++mp) { unsigned q_[2][2];
#pragma unroll
                            for (int e = 0; e < 2; ++e) { const int m = 2 * mp + e; f32x4 v0 = acc[ai][bj][m][0] + bv[bj][0], v1 = acc[ai][bj][m][1] + bv[bj][1];
#pragma unroll
                                for (int j = 0; j < 4; ++j) { v0[j] = sigm(v0[j]); v1[j] = sigm(v1[j]); }
                                unsigned t0_ = 0, t1_ = 0;
                                t0_ = __builtin_amdgcn_cvt_pk_fp8_f32(v0[0], v0[1], t0_, false); t0_ = __builtin_amdgcn_cvt_pk_fp8_f32(v0[2], v0[3], t0_, true);
                                t1_ = __builtin_amdgcn_cvt_pk_fp8_f32(v1[0], v1[1], t1_, false); t1_ = __builtin_amdgcn_cvt_pk_fp8_f32(v1[2], v1[3], t1_, true);
                                q_[e][0] = t0_; q_[e][1] = t1_; }
                            auto r0_ = __builtin_amdgcn_permlane16_swap(q_[0][0], q_[1][0], false, false); auto r1_ = __builtin_amdgcn_permlane16_swap(q_[0][1], q_[1][1], false, false);
                            u32x4 w; w.x = r0_[0]; w.y = r1_[0]; w.z = r0_[1]; w.w = r1_[1];
                            *(u32x4*)((unsigned char*)dst + (size_t)(row0 + ai * HALF + (2 * mp + (fq & 1)) * 16) * 2048 + coff + wc * 32 + 16 * (fq >> 1) + bj * HALF) = w; }
            } else
#pragma unroll
            for (int ai = 0; ai < 2; ++ai)
#pragma unroll
                for (int m = 0; m < 4; ++m) { bf16_t* rowp = dst + (size_t)(row0 + ai * HALF + m * 16) * ldc + coff + c8;
#pragma unroll
                    for (int bj = 0; bj < 2; ++bj) { f32x4 v0 = acc[ai][bj][m][0] + bv[bj][0], v1 = acc[ai][bj][m][1] + bv[bj][1];
                        if (type == T_SILU) {
#pragma unroll
                            for (int j = 0; j < 4; ++j) { v0[j] = v0[j] * sigm(v0[j]); v1[j] = v1[j] * sigm(v1[j]); } }
                        if (type == T_GATE) {
#pragma unroll
                            for (int j = 0; j < 4; ++j) { v0[j] = sigm(v0[j]); v1[j] = sigm(v1[j]); } }
                        {
                        u32x4 w; w.x = cvt_pk_bf16(v0[0], v0[1]); w.y = cvt_pk_bf16(v0[2], v0[3]); w.z = cvt_pk_bf16(v1[0], v1[1]); w.w = cvt_pk_bf16(v1[2], v1[3]);
                        *(u32x4*)(rowp + bj * HALF) = w; } } }
        } else {
            const int trow = wr * 64 + fr;
            const int sec = wc >> 1, i0 = 16 * (wc & 1) + 4 * fq, d0 = 64 * sec + i0;
            f32x4 gA, gB, csT[2][4], snT[2][4];
            if (!IS8) { gA = *(const f32x4*)(gw + c8); gB = *(const f32x4*)(gw + c8 + 4); }
            else { gA = *(const f32x4*)(gw + d0); gB = *(const f32x4*)(gw + d0 + 32);
                const int t0 = u.pm * BM, s0 = t0 < MP ? 0 : MP + (((t0 - MP) >> 11) << 11), gr0 = ((t0 - s0) >> 6) + wr;
                const float* RT = (const float*)(ws + WS_ROPE);
#pragma unroll
                for (int ai = 0; ai < 2; ++ai)
#pragma unroll
                    for (int m = 0; m < 4; ++m) { const int p = sec ? (m * 16 + fr) : (gr0 + 2 * ai); csT[ai][m] = *(const f32x4*)(RT + p * 32 + i0); snT[ai][m] = *(const f32x4*)(RT + 4096 + p * 32 + i0); } }
#pragma unroll
            for (int ai = 0; ai < 2; ++ai)
#pragma unroll
                for (int m = 0; m < 4; ++m)
#pragma unroll
                    for (int bj = 0; bj < 2; ++bj) { const f32x4 a = acc[ai][bj][m][0], b = acc[ai][bj][m][1];
                        float s = (a[0] * a[0] + a[1] * a[1]) + (a[2] * a[2] + a[3] * a[3]) + (b[0] * b[0] + b[1] * b[1]) + (b[2] * b[2] + b[3] * b[3]);
                        s += __shfl_xor(s, 16); s += __shfl_xor(s, 32);
                        if (fq == 0) X[(ai * HALF + m * 16 + trow) * 8 + bj * 4 + wc] = s; }
            asm volatile("s_waitcnt lgkmcnt(0)" ::: "memory"); __builtin_amdgcn_s_barrier(); asm volatile("" ::: "memory");
            if (!IS8 && type == T_NORM) {
                f32x4 g0 = gA * gs, g1 = gB * gs;
#pragma unroll
                for (int ai = 0; ai < 2; ++ai)
#pragma unroll
                    for (int m = 0; m < 4; ++m) { bf16_t* rowp = dst + (size_t)(row0 + ai * HALF + m * 16) * ldc + coff + c8;
#pragma unroll
                        for (int bj = 0; bj < 2; ++bj) { const f32x4 t = *(const PG8_LAS f32x4*)(X + (ai * HALF + m * 16 + trow) * 8 + bj * 4);
                            const float rstd = __builtin_amdgcn_rsqf(((t[0] + t[1]) + (t[2] + t[3])) * (1.0f / 128.0f) + EPS);
                            const f32x4 v0 = acc[ai][bj][m][0] * g0 * rstd, v1 = acc[ai][bj][m][1] * g1 * rstd;
                            u32x4 w; w.x = cvt_pk_bf16(v0[0], v0[1]); w.y = cvt_pk_bf16(v0[2], v0[3]); w.z = cvt_pk_bf16(v1[0], v1[1]); w.w = cvt_pk_bf16(v1[2], v1[3]);
                            *(u32x4*)(rowp + bj * HALF) = w; } }
            } else if (IS8) {
                const f32x4 g1 = gA * gs, g2 = gB * gs;
#define TR4(K) do { auto s0_ = __builtin_amdgcn_permlane32_swap(K[0], K[2], false, false); auto s1_ = __builtin_amdgcn_permlane32_swap(K[1], K[3], false, false); \
                    auto t0_ = __builtin_amdgcn_permlane16_swap(s0_[0], s1_[0], false, false); auto t1_ = __builtin_amdgcn_permlane16_swap(s0_[1], s1_[1], false, false); \
                    K[0] = t0_[0]; K[1] = t0_[1]; K[2] = t1_[0]; K[3] = t1_[1]; } while (0)
                const int dbase = 64 * sec + 16 * (wc & 1);
#pragma unroll
                for (int ai = 0; ai < 2; ++ai)
#pragma unroll
                    for (int bj = 0; bj < 2; ++bj) { unsigned K1[4], K2[4];
#pragma unroll
                        for (int m = 0; m < 4; ++m) { const f32x4 cs = csT[ai][m], sn = snT[ai][m];
                            const f32x4 t = *(const PG8_LAS f32x4*)(X + (ai * HALF + m * 16 + trow) * 8 + bj * 4);
                            const float rstd = __builtin_amdgcn_rsqf(((t[0] + t[1]) + (t[2] + t[3])) * (1.0f / 128.0f) + EPS);
                            const f32x4 x1 = acc[ai][bj][m][0] * g1 * rstd, x2 = acc[ai][bj][m][1] * g2 * rstd;
                            const f32x4 y1 = x1 * cs - x2 * sn, y2 = x2 * cs + x1 * sn;
                            unsigned k1 = 0, k2 = 0; k1 = __builtin_amdgcn_cvt_pk_fp8_f32(y1[0], y1[1], k1, false); k1 = __builtin_amdgcn_cvt_pk_fp8_f32(y1[2], y1[3], k1, true);
                            k2 = __builtin_amdgcn_cvt_pk_fp8_f32(y2[0], y2[1], k2, false); k2 = __builtin_amdgcn_cvt_pk_fp8_f32(y2[2], y2[3], k2, true);
                            K1[m] = k1; K2[m] = k2; }
                        TR4(K1); TR4(K2);
                        const size_t orow = (size_t)(row0 + ai * HALF + fq * 16);
                        unsigned char* r8 = (pn == 20 ? (unsigned char*)(ws + WS_KB) + orow * 256 : (unsigned char*)(ws + WS_QB) + orow * 1024 + coff) + dbase + bj * HALF;
                        u32x4 w1, w2; w1.x = K1[0]; w1.y = K1[1]; w1.z = K1[2]; w1.w = K1[3]; w2.x = K2[0]; w2.y = K2[1]; w2.z = K2[2]; w2.w = K2[3];
                        *(u32x4*)r8 = w1; *(u32x4*)(r8 + 32) = w2; }
#undef TR4
            }
        }
    }
};
struct EpiC1 {
    static constexpr bool PERM = false, AFTER_DRAIN = false, HAS_MID = true; static constexpr int MID_T = 16;
    const bf16_t* GA; const unsigned char* GB; bf16_t* MG;
    static __device__ __forceinline__ void unp8(u32x2 w, f32x4& e0, f32x4& e1) {
        const f32x2 a = __builtin_amdgcn_cvt_pk_f32_fp8(w.x, false), b = __builtin_amdgcn_cvt_pk_f32_fp8(w.x, true), c = __builtin_amdgcn_cvt_pk_f32_fp8(w.y, false), d = __builtin_amdgcn_cvt_pk_f32_fp8(w.y, true);
        e0 = (f32x4){a.x, a.y, b.x, b.y}; e1 = (f32x4){c.x, c.y, d.x, d.y}; }
    __device__ __forceinline__ void second(f32x4 (&)[2][2][4][2], const Unit&, int, int, int, int) const {}
    __device__ __forceinline__ void init(f32x4 (&acc)[2][2][4][2], const Unit&, int, int, int, int) const { acc_zero(acc); }
    __device__ __forceinline__ void mid(f32x4 (&acc)[2][2][4][2], const Unit& u, int wr, int wc, int fr, int fq) const {
        asm volatile("" : "+v"(fr), "+v"(fq));
        const size_t off0 = (size_t)(u.pm * BM + wr * 64 + fr) * DM + u.pn * BM + wc * 32 + 8 * fq;
#pragma unroll
        for (int ai = 0; ai < 2; ++ai) {
            u32x4 a[4][2]; u32x2 b[4][2];
#pragma unroll
            for (int m = 0; m < 4; ++m)
#pragma unroll
                for (int bj = 0; bj < 2; ++bj) { const size_t off = off0 + (size_t)(ai * HALF + m * 16) * DM + bj * HALF; a[m][bj] = *(const u32x4*)(GA + off); b[m][bj] = *(const u32x2*)(GB + off); }
#pragma unroll
            for (int m = 0; m < 4; ++m)
#pragma unroll
                for (int bj = 0; bj < 2; ++bj) { const u32x4 av = a[m][bj]; f32x4 g0, g1; unp8(b[m][bj], g0, g1);
                    f32x4 r0, r1;
                    r0[0] = bflo(av.x) * __builtin_amdgcn_rcpf(g0[0]); r0[1] = bfhi(av.x) * __builtin_amdgcn_rcpf(g0[1]);
                    r0[2] = bflo(av.y) * __builtin_amdgcn_rcpf(g0[2]); r0[3] = bfhi(av.y) * __builtin_amdgcn_rcpf(g0[3]);
                    r1[0] = bflo(av.z) * __builtin_amdgcn_rcpf(g1[0]); r1[1] = bfhi(av.z) * __builtin_amdgcn_rcpf(g1[1]);
                    r1[2] = bflo(av.w) * __builtin_amdgcn_rcpf(g1[2]); r1[3] = bfhi(av.w) * __builtin_amdgcn_rcpf(g1[3]);
                    acc[ai][bj][m][0] = acc[ai][bj][m][0] * (r0 * 4096.0f); acc[ai][bj][m][1] = acc[ai][bj][m][1] * (r1 * 4096.0f); }
            asm volatile("" ::: "memory");
        }
    }
    __device__ __forceinline__ void operator()(f32x4 (&acc)[2][2][4][2], const Unit& u, int wr, int wc, int fr, int fq) const {
        asm volatile("" : "+v"(fr), "+v"(fq));
        const size_t off0 = (size_t)(u.pm * BM + wr * 64 + fr) * DM + u.pn * BM + wc * 32 + 8 * fq;
        u32x2 b[2][4][2];
#pragma unroll
        for (int ai = 0; ai < 2; ++ai)
#pragma unroll
            for (int m = 0; m < 4; ++m)
#pragma unroll
                for (int bj = 0; bj < 2; ++bj) b[ai][m][bj] = *(const u32x2*)(GB + off0 + (size_t)(ai * HALF + m * 16) * DM + bj * HALF);
#pragma unroll
        for (int ai = 0; ai < 2; ++ai)
#pragma unroll
            for (int m = 0; m < 4; ++m)
#pragma unroll
                for (int bj = 0; bj < 2; ++bj) { const size_t off = off0 + (size_t)(ai * HALF + m * 16) * DM + bj * HALF; f32x4 g0, g1; unp8(b[ai][m][bj], g0, g1);
                    const f32x4 v0 = acc[ai][bj][m][0] * (g0 * (1.0f / 4096.0f)), v1 = acc[ai][bj][m][1] * (g1 * (1.0f / 4096.0f));
                    u32x4 w; w.x = cvt_pk_bf16(v0[0], v0[1]); w.y = cvt_pk_bf16(v0[2], v0[3]); w.z = cvt_pk_bf16(v1[0], v1[1]); w.w = cvt_pk_bf16(v1[2], v1[3]);
                    *(u32x4*)(MG + off) = w; }
    }
};
struct EpiC2 {
    static constexpr bool PERM = false, AFTER_DRAIN = false, HAS_MID = false; static constexpr int MID_T = 1 << 30;
    const float* xp; const float* xs; float* out; float pscale;
    __device__ __forceinline__ void second(f32x4 (&)[2][2][4][2], const Unit&, int, int, int, int) const {}
    __device__ __forceinline__ void mid(f32x4 (&)[2][2][4][2], const Unit&, int, int, int, int) const {}
    __device__ __forceinline__ void init(f32x4 (&acc)[2][2][4][2], const Unit& u, int wr, int wc, int fr, int fq) const {
        asm volatile("" : "+v"(fr), "+v"(fq));
        const int col0 = u.pn * BM + wc * 32 + 4 * fq, grow0 = u.pm * BM + wr * 64 + fr;
        const float* xb = (grow0 < MP ? xp + (size_t)grow0 * DM : xs + (size_t)(grow0 - MP) * DM) + col0;
#pragma unroll
        for (int ai = 0; ai < 2; ++ai)
#pragma unroll
            for (int m = 0; m < 4; ++m)
#pragma unroll
                for (int bj = 0; bj < 2; ++bj)
#pragma unroll
                    for (int n = 0; n < 2; ++n) acc[ai][bj][m][n] = __builtin_nontemporal_load((const f32x4*)(xb + (size_t)(ai * HALF + m * 16) * DM + bj * HALF + n * 16));
    }
    __device__ __forceinline__ void operator()(f32x4 (&acc)[2][2][4][2], const Unit& u, int wr, int wc, int fr, int fq) const {
        asm volatile("" : "+v"(fr), "+v"(fq));
        const int col0 = u.pn * BM + wc * 32 + 4 * fq, grow0 = u.pm * BM + wr * 64 + fr;
        float* ob = out + (size_t)grow0 * DM + col0;
#pragma unroll
        for (int ai = 0; ai < 2; ++ai)
#pragma unroll
            for (int m = 0; m < 4; ++m)
#pragma unroll
                for (int bj = 0; bj < 2; ++bj)
#pragma unroll
                    for (int n = 0; n < 2; ++n) __builtin_nontemporal_store(
#ifdef PROBE_T
                        acc[ai][bj][m][n] * pscale,
#else
                        acc[ai][bj][m][n],
#endif
                        (f32x4*)(ob + (size_t)(ai * HALF + m * 16) * DM + bj * HALF + n * 16));
    }
};

typedef int i32x8 __attribute__((ext_vector_type(8)));
typedef int i32x4 __attribute__((ext_vector_type(4)));
__device__ __forceinline__ bf16x8 lo8(i32x8 v) { return __builtin_bit_cast(bf16x8, (i32x4)__builtin_shufflevector(v, v, 0, 1, 2, 3)); }
__device__ __forceinline__ bf16x8 hi8(i32x8 v) { return __builtin_bit_cast(bf16x8, (i32x4)__builtin_shufflevector(v, v, 4, 5, 6, 7)); }
__device__ __forceinline__ i32x8 cat8(bf16x8 a, bf16x8 b) { return __builtin_shufflevector(__builtin_bit_cast(i32x4, a), __builtin_bit_cast(i32x4, b), 0, 1, 2, 3, 4, 5, 6, 7); }
template <class Epi, class Sched, bool ALIGN_EPI = false, bool SP2 = false, bool FP8 = false, bool MIX = false>
__device__ __forceinline__ void gemm_phase(PG8_LAS unsigned char* lds, const Gemm g, const Sched& S, const Epi& E) {
    const int tid = threadIdx.x, wid = __builtin_amdgcn_readfirstlane(tid >> 6), lane = tid & 63, wr = wid >> 2, wc = wid & 3, fr = lane & 15, fq = lane >> 4;
    const int K = g.K, nt = K / BK;
    unsigned voffA[2];
#pragma unroll
    for (int i = 0; i < 2; ++i) { int R, C; stage_rc(tid * 16 + i * 8192, R, C); voffA[i] = (unsigned)(R * K + C) * 2u; }
#define voffB voffA
    const size_t kstep = (size_t)(BK * 2);
    const size_t hstep = (size_t)HALF * K * 2;
    const size_t tstep = 2 * hstep;
    const unsigned ldsw = (unsigned)wid * 1024u;
    const int aoff = lds_byte(wr * 64 + fr, fq * 8), boff = lds_byte(wc * 32 + fr, fq * 8);
#define PG8_SA(b, h) (((b) * 2 + (h)) * HTB)
#define PG8_SB(b, h) ((4 + (b) * 2 + (h)) * HTB)
#define PG8_STAGE(bufoff, gbase, voff) do { _Pragma("unroll") for (int _i = 0; _i < 2; ++_i) \
        __builtin_amdgcn_global_load_lds((const unsigned*)((const char*)(gbase) + (voff)[_i]), (PG8_LAS unsigned*)(lds + (bufoff) + ldsw + _i * 8192), 16, 0, 0); } while (0)
#define PG8_LDA8_(dst, b, h) do { _Pragma("unroll") for (int m = 0; m < 4; ++m) dst##8[m] = cat8(*(const PG8_LAS bf16x8*)(lds + PG8_SA(b, h) + aoff + m * 2048), *(const PG8_LAS bf16x8*)(lds + PG8_SA(b, h) + aoff + m * 2048 + 1024)); } while (0)
#define PG8_LDA16_(dst, b, h) do { _Pragma("unroll") for (int m = 0; m < 4; ++m) _Pragma("unroll") for (int k = 0; k < 2; ++k) dst[m][k] = *(const PG8_LAS bf16x8*)(lds + PG8_SA(b, h) + aoff + m * 2048 + k * 1024); } while (0)
#define PG8_LDB8_(dst, b, h) do { _Pragma("unroll") for (int n = 0; n < 2; ++n) dst##8[n] = cat8(*(const PG8_LAS bf16x8*)(lds + PG8_SB(b, h) + boff + n * 2048), *(const PG8_LAS bf16x8*)(lds + PG8_SB(b, h) + boff + n * 2048 + 1024)); } while (0)
#define PG8_LDB16_(dst, b, h) do { _Pragma("unroll") for (int n = 0; n < 2; ++n) _Pragma("unroll") for (int k = 0; k < 2; ++k) dst[n][k] = *(const PG8_LAS bf16x8*)(lds + PG8_SB(b, h) + boff + n * 2048 + k * 1024); } while (0)
#define PG8_LDA(F8, dst, b, h) do { if constexpr (F8) PG8_LDA8_(dst, b, h); else PG8_LDA16_(dst, b, h); } while (0)
#define PG8_LDB(F8, dst, b, h) do { if constexpr (F8) PG8_LDB8_(dst, b, h); else PG8_LDB16_(dst, b, h); } while (0)
#define PG8_MMA8(ai, bj, At, Bt) do { _Pragma("unroll") for (int m = 0; m < 4; ++m) _Pragma("unroll") for (int n = 0; n < 2; ++n) \
        asm volatile("v_mfma_scale_f32_16x16x128_f8f6f4 %0, %1, %2, %0, %3, %3 op_sel_hi:[0,0,0]" : "+v"(acc[ai][bj][m][n]) : "v"(Bt##8[n]), "v"(At##8[m]), "v"(sc8)); } while (0)
#define PG8_MMA16_(ai, bj, At, Bt) do { _Pragma("unroll") for (int m = 0; m < 4; ++m) _Pragma("unroll") for (int n = 0; n < 2; ++n) _Pragma("unroll") for (int k = 0; k < 2; ++k) \
        acc[ai][bj][m][n] = __builtin_amdgcn_mfma_f32_16x16x32_bf16(Bt[n][k], At[m][k], acc[ai][bj][m][n], 0, 0, 0); } while (0)
#define PG8_MMA(F8, ai, bj, At, Bt) do { __builtin_amdgcn_s_setprio(1); if constexpr (F8) { PG8_MMA8(ai, bj, At, Bt); } else { PG8_MMA16_(ai, bj, At, Bt); } __builtin_amdgcn_s_setprio(0); } while (0)
#define PG8_WAIT_V(n) asm volatile("s_waitcnt vmcnt(" #n ")" ::: "memory")
#define PG8_WAIT_L(n) asm volatile("s_waitcnt lgkmcnt(" #n ")" ::: "memory")
#define PG8_BAR __builtin_amdgcn_s_barrier()
#define PG8_SCHED __builtin_amdgcn_sched_barrier(0)
    Unit cur, nxt; int ui = 0;
    if (!S.next(0, cur)) return;
    f32x4 acc[2][2][4][2];
    E.init(acc, cur, wr, wc, fr, fq);
    bf16x8 At[4][2], B0[2][2], B1[2][2]; i32x8 At8[4], B08[2], B18[2]; int sc8 = (FP8 && !MIX) ? 0x7c7c7c7c : 0x7f7f7f7f; asm volatile("" : "+v"(sc8));
    const char* cA = (const char*)g.A + (size_t)cur.pm * tstep; const char* cB = (const char*)g.Bt + (size_t)cur.pn * tstep;
    S.a_ready(cur);
    if constexpr (SP2) {
        PG8_STAGE(PG8_SB(0, 0), cB, voffB); PG8_STAGE(PG8_SB(0, 1), cB + hstep, voffB); PG8_STAGE(PG8_SA(0, 0), cA, voffA); PG8_STAGE(PG8_SA(0, 1), cA + hstep, voffA);
        if (wr == 1) PG8_BAR;
        PG8_WAIT_V(2); PG8_BAR;
        PG8_STAGE(PG8_SB(1, 0), cB + kstep, voffB); PG8_STAGE(PG8_SA(1, 0), cA + kstep, voffA); PG8_STAGE(PG8_SB(1, 1), cB + hstep + kstep, voffB);
        PG8_WAIT_V(6); PG8_BAR;
    } else {
        PG8_STAGE(PG8_SB(0, 0), cB, voffB); PG8_STAGE(PG8_SA(0, 0), cA, voffA); PG8_STAGE(PG8_SB(0, 1), cB + hstep, voffB); PG8_STAGE(PG8_SA(0, 1), cA + hstep, voffA);
        if (wr == 1) PG8_BAR;
        PG8_WAIT_V(4); PG8_BAR;
        PG8_STAGE(PG8_SB(1, 0), cB + kstep, voffB); PG8_STAGE(PG8_SA(1, 0), cA + kstep, voffA); PG8_STAGE(PG8_SB(1, 1), cB + hstep + kstep, voffB);
        PG8_WAIT_V(6); PG8_BAR;
    }
    for (;;) {
        const bool has_next = S.next(ui + 1, nxt);
        const char* nA = has_next ? (const char*)g.A + (size_t)nxt.pm * tstep : cA; const char* nB = has_next ? (const char*)g.Bt + (size_t)nxt.pn * tstep : cB;
#define PG8_ITER(F8) { \
            const bool last = (t == nt - 2); \
            const char* a1 = cA + (size_t)(t + 1) * kstep; \
            const char* a2 = last ? nA : cA + (size_t)(t + 2) * kstep; const char* b2 = last ? nB : cB + (size_t)(t + 2) * kstep; \
            const char* a3 = a2 + kstep; const char* b3 = b2 + kstep; \
            if (last && has_next) S.a_ready(nxt); \
            PG8_LDB(F8, B0, 0, 0); PG8_LDB(F8, B1, 0, 1); PG8_SCHED; PG8_LDA(F8, At, 0, 0); PG8_STAGE(PG8_SA(1, 1), a1 + hstep, voffA); \
            PG8_WAIT_V(8); PG8_WAIT_L(0); PG8_BAR; PG8_MMA(F8, 0, 0, At, B0); PG8_MMA(F8, 0, 1, At, B1); PG8_BAR; PG8_SCHED; \
            PG8_LDA(F8, At, 0, 1); PG8_STAGE(PG8_SB(0, 0), b2, voffB); PG8_STAGE(PG8_SB(0, 1), b2 + hstep, voffB); PG8_STAGE(PG8_SA(0, 0), a2, voffA); \
            PG8_WAIT_V(8); PG8_WAIT_L(0); PG8_BAR; PG8_MMA(F8, 1, 0, At, B0); PG8_MMA(F8, 1, 1, At, B1); PG8_BAR; PG8_SCHED; \
            PG8_LDB(F8, B0, 1, 0); PG8_LDB(F8, B1, 1, 1); PG8_SCHED; PG8_LDA(F8, At, 1, 0); PG8_STAGE(PG8_SA(0, 1), a2 + hstep, voffA); \
            PG8_WAIT_V(8); PG8_WAIT_L(0); PG8_BAR; PG8_MMA(F8, 0, 0, At, B0); PG8_MMA(F8, 0, 1, At, B1); PG8_BAR; PG8_SCHED; \
            PG8_LDA(F8, At, 1, 1); PG8_STAGE(PG8_SB(1, 0), b3, voffB); PG8_STAGE(PG8_SB(1, 1), b3 + hstep, voffB); PG8_STAGE(PG8_SA(1, 0), a3, voffA); \
            PG8_WAIT_V(8); PG8_WAIT_L(0); PG8_BAR; PG8_MMA(F8, 1, 0, At, B0); PG8_MMA(F8, 1, 1, At, B1); PG8_BAR; PG8_SCHED; }
        static_assert(SP2, "only the two-super-phase K-loop is kept");
        if constexpr (MIX) {
            for (int t = 0; t < Epi::MID_T; t += 2) PG8_ITER(false)
            E.mid(acc, cur, wr, wc, fr, fq);
            for (int t = Epi::MID_T; t < nt; t += 2) PG8_ITER(true)
        } else {
            for (int t = 0; t < nt; t += 2) PG8_ITER(FP8)
        }
        if constexpr (ALIGN_EPI) { if (wr == 0) PG8_BAR; }
        if constexpr (FP8 || MIX) asm volatile("s_nop 15\n\ts_nop 15" ::: "memory");
        E(acc, cur, wr, wc, fr, fq); S.done(cur);
#ifdef PROBE_EPI2
        if (PROBE_EPI2 == 1 || wid == 99) { asm volatile("" ::: "memory"); E(acc, cur, wr, wc, fr, fq); }
        if (PROBE_EPI2 == 2) { asm volatile("" ::: "memory"); E.second(acc, cur, wr, wc, fr, fq); }
#endif
        if (!has_next) break;
        E.init(acc, nxt, wr, wc, fr, fq);
        cur = nxt; cA = nA; cB = nB; ++ui;
        if constexpr (ALIGN_EPI) { if (wr == 1) PG8_BAR; }
    }
    PG8_WAIT_V(0);
    if constexpr (!ALIGN_EPI) { if (wr == 0) PG8_BAR; }
    PG8_BAR;
#undef voffB
#undef PG8_SA
#undef PG8_SB
#undef PG8_STAGE
#undef PG8_LDA
#undef PG8_LDB
#undef PG8_MMA
#undef PG8_MMA8
#undef PG8_ITER
#undef PG8_MMA16_
#undef PG8_LDA8_
#undef PG8_LDA16_
#undef PG8_LDB8_
#undef PG8_LDB16_
#undef PG8_WAIT_V
#undef PG8_WAIT_L
#undef PG8_BAR
#undef PG8_SCHED
}
}

namespace att {
using bf16x8 = __attribute__((ext_vector_type(8))) short;
using s16x4  = __attribute__((ext_vector_type(4))) short;
using f32x16 = __attribute__((ext_vector_type(16))) float;
using f32x4  = __attribute__((ext_vector_type(4))) float;
using u32x4  = __attribute__((ext_vector_type(4))) unsigned;
constexpr int D = 128, NW = 8, QBLK = 32, KVBLK = 64;
constexpr int LDQ = 1024, LDKB = 256, LDOB = 3072;
constexpr size_t SHM_V = KVBLK * D * 2, SHM_K = KVBLK * D * 2, SHM_ATTN = 2 * SHM_V + 2 * SHM_K + NW * 64 * 4;
#define KSWZ(row, colB) ((row) * 256 + ((colB) ^ (((row) & 7) << 4)))
#define SBAR() __builtin_amdgcn_sched_barrier(0)
__device__ __forceinline__ int crow(int r, int hi) { return (r & 3) + 8 * (r >> 2) + 4 * hi; }
__device__ __forceinline__ unsigned cvtpk(float lo, float hi) { unsigned r; asm volatile("v_cvt_pk_bf16_f32 %0, %1, %2" : "=v"(r) : "v"(lo), "v"(hi)); return r; }
__device__ __forceinline__ bf16x8 ld8(const bf16_t* p) { return *reinterpret_cast<const bf16x8*>(p); }

#define PK4(P, BASE, OUT) do { unsigned a0 = cvtpk(P[BASE + 0], P[BASE + 1]), a1 = cvtpk(P[BASE + 2], P[BASE + 3]);   \
    unsigned b0 = cvtpk(P[BASE + 4], P[BASE + 5]), b1 = cvtpk(P[BASE + 6], P[BASE + 7]);                              \
    auto r0 = __builtin_amdgcn_permlane32_swap(a0, b0, false, false); auto r1 = __builtin_amdgcn_permlane32_swap(a1, b1, false, false); \
    u32x4 w = {r0[0], r1[0], r0[1], r1[1]}; OUT = *reinterpret_cast<bf16x8*>(&w); } while (0)
__device__ __forceinline__ void qkt_acc(f32x16& p0, f32x16& p1, const char* Ks, const bf16x8* qr, int ra, int rb, int hi) {
  for (int d0 = 0; d0 < 8; ++d0) { int cb = (d0 * 16 + hi * 8) * 2;
    bf16x8 b0 = *reinterpret_cast<const bf16x8*>(Ks + KSWZ(ra, cb));
    bf16x8 b1 = *reinterpret_cast<const bf16x8*>(Ks + KSWZ(rb, cb));
    p0 = __builtin_amdgcn_mfma_f32_32x32x16_bf16(b0, qr[d0], p0, 0, 0, 0);
    p1 = __builtin_amdgcn_mfma_f32_32x32x16_bf16(b1, qr[d0], p1, 0, 0, 0); }
}
#define KSWZ8(row, ch) ((row) * 128 + ((((ch) ^ (((row) >> 1) & 7))) << 4))
typedef int i32x8 __attribute__((ext_vector_type(8)));
typedef int i32x4 __attribute__((ext_vector_type(4)));
__device__ __forceinline__ i32x8 cat8i(i32x4 a, i32x4 b) { return __builtin_shufflevector(a, b, 0, 1, 2, 3, 4, 5, 6, 7); }
__device__ __forceinline__ void qkt8(f32x16& p0, f32x16& p1, const f32x16& cinit, const char* Ks, const i32x8* q8, int r32, int hi, int sca, int scb) {
  {   const int c0 = 2 * hi;
    const i32x8 a0 = cat8i(*reinterpret_cast<const i32x4*>(Ks + KSWZ8(r32, c0)), *reinterpret_cast<const i32x4*>(Ks + KSWZ8(r32, c0 + 1)));
    const i32x8 a1 = cat8i(*reinterpret_cast<const i32x4*>(Ks + KSWZ8(32 + r32, c0)), *reinterpret_cast<const i32x4*>(Ks + KSWZ8(32 + r32, c0 + 1)));
    p0 = __builtin_amdgcn_mfma_scale_f32_32x32x64_f8f6f4(a0, q8[0], cinit, 0, 0, 0, sca, 0, scb);
    p1 = __builtin_amdgcn_mfma_scale_f32_32x32x64_f8f6f4(a1, q8[0], cinit, 0, 0, 0, sca, 0, scb); }
  {   const int c0 = 2 * hi + 4;
    const i32x8 a0 = cat8i(*reinterpret_cast<const i32x4*>(Ks + KSWZ8(r32, c0)), *reinterpret_cast<const i32x4*>(Ks + KSWZ8(r32, c0 + 1)));
    const i32x8 a1 = cat8i(*reinterpret_cast<const i32x4*>(Ks + KSWZ8(32 + r32, c0)), *reinterpret_cast<const i32x4*>(Ks + KSWZ8(32 + r32, c0 + 1)));
    p0 = __builtin_amdgcn_mfma_scale_f32_32x32x64_f8f6f4(a0, q8[1], p0, 0, 0, 0, sca, 0, scb);
    p1 = __builtin_amdgcn_mfma_scale_f32_32x32x64_f8f6f4(a1, q8[1], p1, 0, 0, 0, sca, 0, scb); }
}
__device__ __forceinline__ int v_st(int k, int c) { const int kk = (k & ~0xC) | ((k & 4) << 1) | ((k & 8) >> 1); return ((kk >> 3) * 4 + (c >> 5)) * 512 + ((kk & 7) * 32 + (c & 31)) * 2; }
__device__ __forceinline__ int v_rd_base(int lane) { return ((lane & 3) << 3) | (((lane >> 2) & 3) << 6) | (((lane >> 4) & 1) << 5) | (((lane >> 5) & 1) << 8); }
constexpr int v_rd_off(int d0, int ks, int half) { return d0 * 512 + ks * 4096 + half * 2048; }
template <int OFF> __device__ __forceinline__ s16x4 tr_read(int vb) {
  s16x4 r; asm volatile("ds_read_b64_tr_b16 %0, %1 offset:%2" : "=&v"(r) : "v"(vb), "i"(OFF) : "memory"); return r;
}
template <int D0> __device__ __forceinline__ void pv_one(f32x16& od, int vb, bf16x8 pa0, bf16x8 pa1, bf16x8 pa2, bf16x8 pa3) {
  const s16x4 l0 = tr_read<v_rd_off(D0, 0, 0)>(vb), h0 = tr_read<v_rd_off(D0, 0, 1)>(vb), l1 = tr_read<v_rd_off(D0, 1, 0)>(vb), h1 = tr_read<v_rd_off(D0, 1, 1)>(vb);
  const s16x4 l2 = tr_read<v_rd_off(D0, 2, 0)>(vb), h2 = tr_read<v_rd_off(D0, 2, 1)>(vb), l3 = tr_read<v_rd_off(D0, 3, 0)>(vb), h3 = tr_read<v_rd_off(D0, 3, 1)>(vb);
  asm volatile("s_waitcnt lgkmcnt(0)" ::: "memory"); SBAR();
#define PK(L, H) (bf16x8){L[0], L[1], L[2], L[3], H[0], H[1], H[2], H[3]}
  od = __builtin_amdgcn_mfma_f32_32x32x16_bf16(pa0, PK(l0, h0), od, 0, 0, 0);
  od = __builtin_amdgcn_mfma_f32_32x32x16_bf16(pa1, PK(l1, h1), od, 0, 0, 0);
  od = __builtin_amdgcn_mfma_f32_32x32x16_bf16(pa2, PK(l2, h2), od, 0, 0, 0);
  od = __builtin_amdgcn_mfma_f32_32x32x16_bf16(pa3, PK(l3, h3), od, 0, 0, 0);
#undef PK
}
__device__ __forceinline__ void pv_d0(f32x16* o, int vb, bf16x8 pa0, bf16x8 pa1, bf16x8 pa2, bf16x8 pa3) {
  pv_one<0>(o[0], vb, pa0, pa1, pa2, pa3); pv_one<1>(o[1], vb, pa0, pa1, pa2, pa3); pv_one<2>(o[2], vb, pa0, pa1, pa2, pa3); pv_one<3>(o[3], vb, pa0, pa1, pa2, pa3);
}
template <int D0> __device__ __forceinline__ void pv_one3(f32x16& od, int vb, bf16x8 pa0, bf16x8 pa1, bf16x8 pa2) {
  const s16x4 l0 = tr_read<v_rd_off(D0, 0, 0)>(vb), h0 = tr_read<v_rd_off(D0, 0, 1)>(vb), l1 = tr_read<v_rd_off(D0, 1, 0)>(vb), h1 = tr_read<v_rd_off(D0, 1, 1)>(vb);
  const s16x4 l2 = tr_read<v_rd_off(D0, 2, 0)>(vb), h2 = tr_read<v_rd_off(D0, 2, 1)>(vb);
  asm volatile("s_waitcnt lgkmcnt(0)" ::: "memory"); SBAR();
#define PK(L, H) (bf16x8){L[0], L[1], L[2], L[3], H[0], H[1], H[2], H[3]}
  od = __builtin_amdgcn_mfma_f32_32x32x16_bf16(pa0, PK(l0, h0), od, 0, 0, 0);
  od = __builtin_amdgcn_mfma_f32_32x32x16_bf16(pa1, PK(l1, h1), od, 0, 0, 0);
  od = __builtin_amdgcn_mfma_f32_32x32x16_bf16(pa2, PK(l2, h2), od, 0, 0, 0);
#undef PK
}
__device__ __forceinline__ void pv_d03(f32x16* o, int vb, bf16x8 pa0, bf16x8 pa1, bf16x8 pa2) {
  pv_one3<0>(o[0], vb, pa0, pa1, pa2); pv_one3<1>(o[1], vb, pa0, pa1, pa2); pv_one3<2>(o[2], vb, pa0, pa1, pa2); pv_one3<3>(o[3], vb, pa0, pa1, pa2);
}
template <bool F8OUT> __device__ __forceinline__ void store_o(const f32x16* o, float l_full, const bf16_t* __restrict__ Zw, unsigned char* __restrict__ Ow, float* li_l, float* ost, int lane, int r32, int hi) {
  asm volatile("" : "+v"(r32), "+v"(hi), "+v"(lane));
  const int rrow = lane >> 3, c8 = (lane & 7) * 8;
  u32x4 zz[2][4];
#pragma unroll
  for (int ps = 0; ps < 2; ++ps)
#pragma unroll
    for (int it = 0; it < 4; ++it) zz[ps][it] = *(const u32x4*)(Zw + (size_t)(8 * it + rrow) * LDQ + ps * 64 + c8);
  if (hi == 0) li_l[r32] = l_full; asm volatile("s_waitcnt lgkmcnt(0)" ::: "memory");
  float rli[16];
#pragma unroll
  for (int r = 0; r < 16; ++r) rli[r] = __builtin_amdgcn_rcpf(li_l[crow(r, hi)]);
  const int r32x = r32 ^ 4, sw = (rrow & 1) << 2;
#pragma unroll
  for (int ps = 0; ps < 2; ++ps) {
#pragma unroll
    for (int r = 0; r < 16; ++r) { const int orow = crow(r, hi), cc = (r & 1) ? r32x : r32;
      ost[orow * 64 + cc] = o[2 * ps][r] * rli[r]; ost[orow * 64 + 32 + cc] = o[2 * ps + 1][r] * rli[r]; }
    asm volatile("s_waitcnt lgkmcnt(0)" ::: "memory");
#pragma unroll
    for (int it = 0; it < 4; ++it) { const int row = 8 * it + rrow;
      const f32x4 v0 = *(const f32x4*)(ost + row * 64 + (c8 ^ sw)), v1 = *(const f32x4*)(ost + row * 64 + ((c8 + 4) ^ sw));
      const u32x4 zq = zz[ps][it];
      const float e0 = v0[0] * __uint_as_float(zq.x << 16), e1 = v0[1] * __uint_as_float(zq.x & 0xffff0000u), e2 = v0[2] * __uint_as_float(zq.y << 16), e3 = v0[3] * __uint_as_float(zq.y & 0xffff0000u);
      const float e4 = v1[0] * __uint_as_float(zq.z << 16), e5 = v1[1] * __uint_as_float(zq.z & 0xffff0000u), e6 = v1[2] * __uint_as_float(zq.w << 16), e7 = v1[3] * __uint_as_float(zq.w & 0xffff0000u);
      if (F8OUT) { unsigned w0 = 0, w1 = 0;
        w0 = __builtin_amdgcn_cvt_pk_fp8_f32(e0 * 64.f, e1 * 64.f, w0, false); w0 = __builtin_amdgcn_cvt_pk_fp8_f32(e2 * 64.f, e3 * 64.f, w0, true);
        w1 = __builtin_amdgcn_cvt_pk_fp8_f32(e4 * 64.f, e5 * 64.f, w1, false); w1 = __builtin_amdgcn_cvt_pk_fp8_f32(e6 * 64.f, e7 * 64.f, w1, true);
        *(unsigned long long*)(Ow + (size_t)row * LDOB + ps * 64 + c8) = (unsigned long long)w0 | ((unsigned long long)w1 << 32); }
      else { u32x4 w; w.x = cvtpk(e0, e1); w.y = cvtpk(e2, e3); w.z = cvtpk(e4, e5); w.w = cvtpk(e6, e7);
        *(u32x4*)(Ow + (size_t)row * LDOB + (ps * 64 + c8) * 2) = w; } }
    asm volatile("s_waitcnt lgkmcnt(0)" ::: "memory");
  }
}

__device__ __forceinline__ void smA(f32x16& p0, f32x16& p1, float negB) {
  for (int r = 0; r < 16; ++r) p0[r] = __builtin_amdgcn_exp2f(p0[r]); for (int r = 0; r < 16; ++r) p1[r] = __builtin_amdgcn_exp2f(p1[r]);
}
__device__ __forceinline__ void smB(f32x16& p0, f32x16& p1, float& l_reg, bf16x8& pa0, bf16x8& pa1, bf16x8& pa2, bf16x8& pa3) {
  float ps = 0; for (int r = 0; r < 16; ++r) ps += p0[r]; for (int r = 0; r < 16; ++r) ps += p1[r];
  l_reg += ps;
  PK4(p0, 0, pa0); PK4(p0, 8, pa1); PK4(p1, 0, pa2); PK4(p1, 8, pa3);
}
__device__ __forceinline__ f32x16 splat16(float v) { f32x16 r; for (int i = 0; i < 16; ++i) r[i] = v; return r; }
__device__ __forceinline__ void gqa_unit(const unsigned char* __restrict__ Qb8, const unsigned char* __restrict__ Kh8, const bf16_t* __restrict__ Vh, const bf16_t* __restrict__ Zb, unsigned char* __restrict__ Ob, int seq, float negB, char* lds) {
  const int tid = threadIdx.x, wid = tid >> 6, lane = tid & 63, r32 = lane & 31, hi = lane >> 5;
  char* V_lds = lds; char* K_lds = lds + 2 * SHM_V;
  float* li_l = (float*)(lds + 2 * SHM_V + 2 * SHM_K) + wid * 64; float* ost = (float*)(lds + SHM_ATTN) + wid * 2048;
  float l_reg = 0; f32x16 o[4] = {}; i32x8 q8[2]; int sca = 0x7c7c7c7c, scb = 0x7f7f7f7f; asm volatile("" : "+v"(sca), "+v"(scb));
  f32x16 cB = splat16(negB); asm volatile("" : "+v"(cB));
  {
    const unsigned char* Qw = Qb8 + (size_t)(wid * QBLK + r32) * 1024 + hi * 32;
#pragma unroll
    for (int s_ = 0; s_ < 2; ++s_) q8[s_] = cat8i(*reinterpret_cast<const i32x4*>(Qw + s_ * 64), *reinterpret_cast<const i32x4*>(Qw + s_ * 64 + 16)); }
  const int vb0 = (int)(uintptr_t)V_lds + v_rd_base(lane);
  typedef __attribute__((address_space(3))) unsigned lds_u32;
  __attribute__((address_space(3))) char* Ll = (__attribute__((address_space(3))) char*)lds;
  const int wu = __builtin_amdgcn_readfirstlane(wid);
  const int krow = tid >> 3; const unsigned koff = (unsigned)krow * 256u + (unsigned)(((tid & 7) ^ ((krow >> 1) & 7)) << 4);
  unsigned voff[2];
#pragma unroll
  for (int i = 0; i < 2; ++i) { const int q = i * 512 + tid, blk = q >> 5, kk = (blk >> 2) * 8 + ((q >> 2) & 7), k = (kk & ~0xC) | ((kk & 4) << 1) | ((kk & 8) >> 1), c = (blk & 3) * 32 + (q & 3) * 8;
    voff[i] = (unsigned)(k * LDKB + c) * 2u; }
#define KDMA(st, k0) __builtin_amdgcn_global_load_lds((const unsigned*)(Kh8 + (size_t)(k0) * 256 + koff), (lds_u32*)(Ll + 2 * SHM_V + (st) * SHM_K + wu * 1024), 16, 0, 0)
#define VDMA(st, k0) do { _Pragma("unroll") for (int i_ = 0; i_ < 2; ++i_) \
    __builtin_amdgcn_global_load_lds((const unsigned*)((const char*)Vh + (size_t)(k0) * (LDKB * 2) + voff[i_]), (lds_u32*)(Ll + (st) * SHM_V + i_ * 8192 + wu * 1024), 16, 0, 0); } while (0)
#define DWAIT() asm volatile("s_waitcnt vmcnt(0)" ::: "memory")
  f32x16 pA0, pA1, pB0, pB1; bf16x8 pa0, pa1, pa2, pa3; const int NT = seq / KVBLK;
  __syncthreads();
  KDMA(0, 0); VDMA(0, 0); KDMA(1, KVBLK); DWAIT(); __syncthreads();
  qkt8(pA0, pA1, cB, K_lds, q8, r32, hi, sca, scb); smA(pA0, pA1, negB);
  __syncthreads();
  for (int j = 0; j + 2 < NT; j += 2) {
    KDMA(0, (j + 2) * KVBLK); VDMA(1, (j + 1) * KVBLK);
    SBAR(); qkt8(pB0, pB1, cB, K_lds + SHM_K, q8, r32, hi, sca, scb);
    smB(pA0, pA1, l_reg, pa0, pa1, pa2, pa3); SBAR();
    pv_d0(o, vb0, pa0, pa1, pa2, pa3); smA(pB0, pB1, negB);
    DWAIT(); __syncthreads();
    if (j + 3 < NT) KDMA(1, (j + 3) * KVBLK);
    VDMA(0, (j + 2) * KVBLK);
    SBAR(); qkt8(pA0, pA1, cB, K_lds, q8, r32, hi, sca, scb);
    smB(pB0, pB1, l_reg, pa0, pa1, pa2, pa3); SBAR();
    pv_d0(o, vb0 + (int)SHM_V, pa0, pa1, pa2, pa3); smA(pA0, pA1, negB);
    DWAIT(); __syncthreads();
  }
  VDMA(1, (NT - 1) * KVBLK);
  SBAR(); qkt8(pB0, pB1, cB, K_lds + SHM_K, q8, r32, hi, sca, scb);
  smB(pA0, pA1, l_reg, pa0, pa1, pa2, pa3); SBAR();
  pv_d0(o, vb0, pa0, pa1, pa2, pa3); smA(pB0, pB1, negB);
  DWAIT(); __syncthreads();
  smB(pB0, pB1, l_reg, pa0, pa1, pa2, pa3); SBAR();
  pv_d0(o, vb0 + (int)SHM_V, pa0, pa1, pa2, pa3);
#undef KDMA
#undef VDMA
#undef DWAIT
  { auto rr = __builtin_amdgcn_permlane32_swap(__float_as_uint(l_reg), __float_as_uint(l_reg), false, false); l_reg = __uint_as_float(rr[0]) + __uint_as_float(rr[1]); }
  {   int t2 = threadIdx.x; asm volatile("" : "+v"(t2));
    const int lane2 = t2 & 63, w2 = __builtin_amdgcn_readfirstlane(t2 >> 6);
    store_o<true>(o, l_reg, Zb + (size_t)(w2 * QBLK) * LDQ, Ob + (size_t)(w2 * QBLK) * LDOB, (float*)(lds + 2 * SHM_V + 2 * SHM_K) + w2 * 64, (float*)(lds + SHM_ATTN) + w2 * 2048, lane2, lane2 & 31, lane2 >> 5); }
}

__device__ __forceinline__ int clampi(int v, int lo, int hi) { return v < lo ? lo : (v > hi ? hi : v); }
__device__ __forceinline__ void na_unit(const bf16_t* __restrict__ Q, const bf16_t* __restrict__ K, const bf16_t* __restrict__ V, const bf16_t* __restrict__ Z, unsigned char* __restrict__ O,
                                        const float* __restrict__ BT, int m0, int s0, int R, int h, char* lds) {
  const int tid = threadIdx.x, wid = __builtin_amdgcn_readfirstlane(tid >> 6), lane = tid & 63, r32 = lane & 31, hi = lane >> 5;
  char* V_lds = lds; char* K_lds = lds + 2 * SHM_V;
  float* li_l = (float*)(lds + 2 * SHM_V + 2 * SHM_K) + wid * 64;
  const int r0 = (m0 - s0) >> 6, r = r0 + (wid >> 1), half = wid & 1;
  const int rs = clampi(r - 4, 0, R - 8), lo = clampi(r0 - 4, 0, R - 8), NT = clampi(r0 - 1, 0, R - 8) + 8 - lo;
  bf16x8 qr[8];
  const bf16_t* Qw = Q + (size_t)(m0 + wid * QBLK + r32) * LDQ + h * D + hi * 8;
#pragma unroll
  for (int d0 = 0; d0 < 8; ++d0) qr[d0] = ld8(Qw + d0 * 16);
  const int ra = r32 + 16 * half, rb = (32 + r32 + 16 * half) & 63;
  const int vb0 = (int)(uintptr_t)V_lds + v_rd_base(lane) + 4096 * half;
  typedef __attribute__((address_space(3))) unsigned lds_u32;
  __attribute__((address_space(3))) char* Ll = (__attribute__((address_space(3))) char*)lds;
  const char* Kg = (const char*)(K + (size_t)(s0 + 64 * lo) * LDQ + h * D); const char* Vg = (const char*)(V + (size_t)(s0 + 64 * lo) * LDQ + h * D);
  unsigned koff[2], voff[2];
#pragma unroll
  for (int i = 0; i < 2; ++i) { const int q = i * 512 + tid;
    { const int row = q >> 4, ch = (q & 15) ^ (row & 7); koff[i] = (unsigned)(row * LDQ + ch * 8) * 2u; }
    { const int blk = q >> 5, kk = (blk >> 2) * 8 + ((q >> 2) & 7), k = (kk & ~0xC) | ((kk & 4) << 1) | ((kk & 8) >> 1), c = (blk & 3) * 32 + (q & 3) * 8; voff[i] = (unsigned)(k * LDQ + c) * 2u; } }
#define NDMA(b, j) do { _Pragma("unroll") for (int i_ = 0; i_ < 2; ++i_) { \
    __builtin_amdgcn_global_load_lds((const unsigned*)(Kg + (size_t)(j) * 131072 + koff[i_]), (lds_u32*)(Ll + 2 * SHM_V + (b) * SHM_K + i_ * 8192 + wid * 1024), 16, 0, 0); \
    __builtin_amdgcn_global_load_lds((const unsigned*)(Vg + (size_t)(j) * 131072 + voff[i_]), (lds_u32*)(Ll + (b) * SHM_V + i_ * 8192 + wid * 1024), 16, 0, 0); } } while (0)
#define DWAIT() asm volatile("s_waitcnt vmcnt(0)" ::: "memory")
  f32x16 o[4] = {}; float l = 0.f;
  float* ost = (float*)(lds + SHM_ATTN) + wid * 2048;
  const int NTp = (NT + 1) & ~1;
  const float* btw = BT + ((size_t)((h * 15) * 2 + half) * 8 * 64 + lane) * 4;
#define ACTIVE(j) ((lo + (j)) >= rs && (lo + (j)) < rs + 8)
#define BLOAD(P0, P1, j) do { if (ACTIVE(j)) { const float* bt = btw + (size_t)(lo + (j) - r + 7) * 4096; \
      _Pragma("unroll") for (int i = 0; i < 4; ++i) { const f32x4 t = *(const f32x4*)(bt + i * 256); P0[4 * i] = t[0]; P0[4 * i + 1] = t[1]; P0[4 * i + 2] = t[2]; P0[4 * i + 3] = t[3]; } \
      _Pragma("unroll") for (int i = 0; i < 2; ++i) { const f32x4 t = *(const f32x4*)(bt + (4 + i) * 256); P1[4 * i] = t[0]; P1[4 * i + 1] = t[1]; P1[4 * i + 2] = t[2]; P1[4 * i + 3] = t[3]; } \
      _Pragma("unroll") for (int i = 8; i < 16; ++i) P1[i] = 0.f; } } while (0)
#define NCOMP(P0, P1, b, nb) do { qkt_acc(P0, P1, K_lds + (b) * SHM_K, qr, ra, rb, hi); \
      _Pragma("unroll") for (int q = 0; q < 16; ++q) P0[q] = __builtin_amdgcn_exp2f(P0[q]); _Pragma("unroll") for (int q = 0; q < 8; ++q) P1[q] = __builtin_amdgcn_exp2f(P1[q]); \
      float ps = 0.f; _Pragma("unroll") for (int q = 0; q < 16; ++q) ps += P0[q]; _Pragma("unroll") for (int q = 0; q < 8; ++q) ps += P1[q]; l += ps; \
      bf16x8 pa0, pa1, pa2; PK4(P0, 0, pa0); PK4(P0, 8, pa1); PK4(P1, 0, pa2); \
      if (nb >= 0) BLOAD(P0, P1, nb); SBAR(); \
      pv_d03(o, vb0 + (b) * (int)SHM_V, pa0, pa1, pa2); } while (0)
  f32x16 pA0 = {}, pA1 = {};
  __syncthreads();
  NDMA(0, 0); BLOAD(pA0, pA1, 0); DWAIT();
  for (int j = 0; j < NTp; j += 2) {
    __syncthreads();
    NDMA(1, j + 1);
    if (ACTIVE(j)) NCOMP(pA0, pA1, 0, j + 1); else BLOAD(pA0, pA1, j + 1);
    DWAIT();
    __syncthreads();
    if (j + 2 < NTp) NDMA(0, j + 2);
    const int nb2 = j + 2 < NTp ? j + 2 : -1;
    if (ACTIVE(j + 1)) NCOMP(pA0, pA1, 1, nb2); else if (nb2 >= 0) BLOAD(pA0, pA1, nb2);
    DWAIT();
  }
  { auto rr = __builtin_amdgcn_permlane32_swap(__float_as_uint(l), __float_as_uint(l), false, false); l = __uint_as_float(rr[0]) + __uint_as_float(rr[1]); }
  store_o<false>(o, l, Z + (size_t)(m0 + wid * QBLK) * LDQ + h * D, O + (size_t)(m0 + wid * QBLK) * LDOB + h * D * 2, li_l, ost, lane, r32, hi);
#undef ACTIVE
#undef BLOAD
#undef NCOMP
#undef NDMA
#undef DWAIT
}
#undef PK4
#undef SBAR
}

constexpr int NWAVES = 8;
constexpr int RING_OFF = 0, RING_BYTES = 131072;
constexpr int XCH_OFF = RING_BYTES, XCH_BYTES = 8192;
constexpr int LDSCTL_OFF = XCH_OFF + XCH_BYTES, MISC_OFF = LDSCTL_OFF + 320;
constexpr int LDS_BYTES = 147456;
static_assert(MISC_OFF + 128 <= LDS_BYTES, "LDS map");
constexpr size_t CTL_ZERO_BYTES = 256 * 1024;
constexpr int CW_BAR = 4096;

#define GAS __attribute__((address_space(1)))
#define LAS __attribute__((address_space(3)))
typedef unsigned v4u __attribute__((ext_vector_type(4)));
typedef float f32x4 __attribute__((ext_vector_type(4)));
typedef GAS unsigned gu32;
#define LDS_WAIT() asm volatile("s_waitcnt lgkmcnt(0)" ::: "memory")
#define VM_WAIT() asm volatile("s_waitcnt vmcnt(0)" ::: "memory")
__device__ __forceinline__ unsigned pk2(float lo, float hi) { return pg8::cvt_pk_bf16(lo, hi); }

#define XB_TMO      128
#define XB_XCNT(j)  (256  + 64 * (j))
#define XB_XSUB(j)  (1280 + 64 * (j))
#define XB_XGEN(j)  (2304 + 64 * (j))
#define XB_TOP      3328
#define XB_TOPGEN   3392
#define XCD_BAR_WORDS 3456
#define XB_SPIN_CAP (1u << 22)
__device__ __forceinline__ unsigned xb_ld(unsigned* p)              { return __hip_atomic_load(p, __ATOMIC_RELAXED, __HIP_MEMORY_SCOPE_AGENT); }
__device__ __forceinline__ unsigned xb_add(unsigned* p, unsigned v) { return __hip_atomic_fetch_add(p, v, __ATOMIC_RELAXED, __HIP_MEMORY_SCOPE_AGENT); }
__device__ __forceinline__ unsigned xb_xcc_id() { return (unsigned)__builtin_amdgcn_s_getreg((3 << 11) | 20) & 0xFu; }
#define XB_SPIN(cond, bar) do { unsigned _sp = 0; while (cond) { __builtin_amdgcn_s_sleep(1); \
    if ((++_sp & 255u) == 0u) { if (xb_ld(&(bar)[XB_TMO])) break; if (_sp > XB_SPIN_CAP) { atomicAdd(&(bar)[XB_TMO], 1u); break; } } } } while (0)
struct XcdBarrier { unsigned* bar; unsigned x; volatile LAS unsigned* st; };
__device__ __forceinline__ XcdBarrier xcd_barrier_post(unsigned* bar, volatile LAS unsigned* st) {
    XcdBarrier b; b.bar = bar; b.x = xb_xcc_id(); b.st = st;
    if (threadIdx.x == 0) (void)xb_add(&bar[XB_XCNT(b.x)], 1u);
    return b;
}
__device__ __forceinline__ void xcd_barrier_complete(unsigned* bar, unsigned x, unsigned& nloc, unsigned& nx) {
    const unsigned G = gridDim.x * gridDim.y * gridDim.z;
    unsigned sum, cnt, mine, sp = 0u;
    for (;;) {
        sum = 0u; cnt = 0u; mine = 0u;
#pragma unroll
        for (unsigned j = 0; j < 16; ++j) { const unsigned c = xb_ld(&bar[XB_XCNT(j)]); sum += c; cnt += (c > 0u) ? 1u : 0u; mine = (j == x) ? c : mine; }
        if (sum == G) break;
        __builtin_amdgcn_s_sleep(1);
        if ((++sp & 255u) == 0u) { if (xb_ld(&bar[XB_TMO])) break; if (sp > XB_SPIN_CAP) { atomicAdd(&bar[XB_TMO], 1u); break; } }
    }
    nloc = mine > 0u ? mine : 1u; nx = cnt > 0u ? cnt : 1u;
}
__device__ __forceinline__ void xcd_barrier(const XcdBarrier& b) {
    asm volatile("s_waitcnt vmcnt(0)" ::: "memory");
    __syncthreads();
    if (threadIdx.x == 0) {
        unsigned* bar = b.bar;
        __builtin_amdgcn_s_waitcnt(0);
        unsigned nloc = b.st[0], nx = b.st[1];
        if (nloc == 0u) { xcd_barrier_complete(bar, b.x, nloc, nx); b.st[0] = nloc; b.st[1] = nx; }
        const unsigned old = xb_add(&bar[XB_XSUB(b.x)], 1u);
        const unsigned gen = old / nloc;
        if (old + 1u == (gen + 1u) * nloc) {
            __builtin_amdgcn_fence(__ATOMIC_RELEASE, "agent");
            asm volatile("s_waitcnt vmcnt(0)" ::: "memory");
            const unsigned og = xb_add(&bar[XB_TOP], 1u);
            const unsigned tg = og / nx;
            if (og + 1u == (tg + 1u) * nx) xb_add(&bar[XB_TOPGEN], 1u);
            else XB_SPIN(xb_ld(&bar[XB_TOPGEN]) == tg, bar);
            __builtin_amdgcn_fence(__ATOMIC_ACQUIRE, "agent");
            xb_add(&bar[XB_XGEN(b.x)], 1u);
            asm volatile("s_waitcnt vmcnt(0)" ::: "memory");
        } else {
            XB_SPIN(xb_ld(&bar[XB_XGEN(b.x)]) == gen, bar);
            __builtin_amdgcn_fence(__ATOMIC_ACQUIRE, "agent");
            asm volatile("s_waitcnt vmcnt(0)" ::: "memory");
        }
    }
    __syncthreads();
}

__device__ __forceinline__ float wave_sum(float v) {
#pragma unroll
    for (int o = 1; o < 64; o <<= 1) v += __shfl_xor(v, o);
    return v;
}
__device__ __forceinline__ float wave_max(float v) {
#pragma unroll
    for (int o = 1; o < 64; o <<= 1) v = fmaxf(v, __shfl_xor(v, o));
    return v;
}
__device__ __forceinline__ int rowmap(int kind, int n) {
    if (kind == 1) { const int cc = n & 31; return (n & ~31) + 16 * ((cc >> 2) & 1) + 4 * (cc >> 3) + (cc & 3); }
    if (kind == 2) { const int d = n & 127; return (n & ~127) + 32 * (2 * (d >> 6) + ((d >> 4) & 1)) + 16 * ((d >> 5) & 1) + 4 * ((d >> 2) & 3) + (d & 3); }
    return n;
}
__device__ __forceinline__ unsigned pk4_fp8(float a, float b, float c, float d) { unsigned w = 0; w = __builtin_amdgcn_cvt_pk_fp8_f32(a, b, w, false); w = __builtin_amdgcn_cvt_pk_fp8_f32(c, d, w, true); return w; }
__device__ __forceinline__ void p0_transpose_item(const float* W, int N, bf16_t* WT, int ldk, int koff, int kind, LAS float* scr, int item, int lane, int row0sel, bool f8) {
    const int nblk = N / 32, kb = item / nblk, nb = item % nblk, k0 = 64 * kb, n0 = 32 * nb;
    const int row0 = row0sel >= 0 ? row0sel : (n0 & ~255);
    float wv[32]; const float* wb = W + (size_t)k0 * N + n0; const unsigned lo_ = (unsigned)(lane >> 5) * (unsigned)N + (unsigned)(lane & 31);
#pragma unroll
    for (int i = 0; i < 32; ++i) wv[i] = __builtin_nontemporal_load(wb + (size_t)(2 * i) * N + lo_);
#pragma unroll
    for (int i = 0; i < 32; ++i) scr[(2 * i + (lane >> 5)) * 33 + (lane & 31)] = wv[i];
    LDS_WAIT(); asm volatile("" ::: "memory");
    const int c = lane & 7;
#pragma unroll
    for (int j = 0; j < 4; ++j) { const int n = (lane >> 3) + 8 * j; const LAS float* s = scr + (8 * c) * 33 + n;
        if (f8) { unsigned long long o8 = (unsigned long long)pk4_fp8(s[0 * 33] * 64.f, s[1 * 33] * 64.f, s[2 * 33] * 64.f, s[3 * 33] * 64.f) | ((unsigned long long)pk4_fp8(s[4 * 33] * 64.f, s[5 * 33] * 64.f, s[6 * 33] * 64.f, s[7 * 33] * 64.f) << 32);
            *(GAS unsigned long long*)((unsigned char*)WT + (size_t)(row0 + rowmap(kind, (n0 & 255) + n)) * ldk + koff + k0 + 8 * c) = o8; }
        else { v4u o; o.x = pk2(s[0 * 33], s[1 * 33]); o.y = pk2(s[2 * 33], s[3 * 33]); o.z = pk2(s[4 * 33], s[5 * 33]); o.w = pk2(s[6 * 33], s[7 * 33]);
            *(GAS v4u*)(WT + (size_t)(row0 + rowmap(kind, (n0 & 255) + n)) * ldk + koff + k0 + 8 * c) = o; } }
    LDS_WAIT(); asm volatile("" ::: "memory");
}
__device__ __forceinline__ void rms_row_to_bf16(const float* xr_, const float* g_, bf16_t* orow, unsigned char* orow8, int lane) {
    const GAS f32x4* xr = (const GAS f32x4*)xr_ + lane; const GAS f32x4* gr = (const GAS f32x4*)g_ + lane;
    f32x4 v[8]; float s = 0.f;
#pragma unroll
    for (int j = 0; j < 8; ++j) { v[j] = __builtin_nontemporal_load(xr + 64 * j); s += (v[j].x * v[j].x + v[j].y * v[j].y) + (v[j].z * v[j].z + v[j].w * v[j].w); }
    const float rstd = 1.0f / sqrtf(wave_sum(s) * (1.f / DM) + EPS);
    GAS unsigned long long* o8 = (GAS unsigned long long*)orow + lane; GAS unsigned* o4 = (GAS unsigned*)orow8 + lane;
#pragma unroll
    for (int j = 0; j < 8; ++j) { const f32x4 g = gr[64 * j]; const float h0 = v[j].x * rstd * g.x, h1 = v[j].y * rstd * g.y, h2 = v[j].z * rstd * g.z, h3 = v[j].w * rstd * g.w;
        o8[64 * j] = (unsigned long long)pk2(h0, h1) | ((unsigned long long)pk2(h2, h3) << 32); o4[64 * j] = pk4_fp8(h0, h1, h2, h3); }
}

template <int NR> __device__ __forceinline__ void rms_load(const Ptrs& P, int m0, int lane, f32x4 (&v)[NR][8]) {
    const GAS f32x4* xr = (const GAS f32x4*)(m0 < MP ? P.xp + (size_t)m0 * DM : P.xs + (size_t)(m0 - MP) * DM) + lane;
#pragma unroll
    for (int r = 0; r < NR; ++r)
#pragma unroll
        for (int j = 0; j < 8; ++j) v[r][j] = __builtin_nontemporal_load(xr + (size_t)r * (DM / 4) + 64 * j);
}
template <int NR, bool GP = false, bool NOST = false> __device__ __forceinline__ void rms_store(const Ptrs& P, int m0, int lane, const f32x4 (&v)[NR][8], const f32x4 (&g_)[8]) {
    unsigned long long ck = 0;
    float rstd[NR];
#pragma unroll
    for (int r = 0; r < NR; ++r) { float s = 0.f;
#pragma unroll
        for (int j = 0; j < 8; ++j) s += (v[r][j].x * v[r][j].x + v[r][j].y * v[r][j].y) + (v[r][j].z * v[r][j].z + v[r][j].w * v[r][j].w);
        rstd[r] = 1.0f / sqrtf(wave_sum(s) * (1.f / DM) + EPS); }
    GAS unsigned long long* o8 = (GAS unsigned long long*)(P.ws + WS_H + (size_t)m0 * DM * 2) + lane; GAS unsigned* o4 = (GAS unsigned*)(P.ws + WS_H8 + (size_t)m0 * DM) + lane;
#pragma unroll
    for (int j = 0; j < 8; ++j) { const f32x4 g = GP ? ((const GAS f32x4*)P.norm_g)[lane + 64 * j] : g_[j];
#pragma unroll
        for (int r = 0; r < NR; ++r) { const float h0 = v[r][j].x * rstd[r] * g.x, h1 = v[r][j].y * rstd[r] * g.y, h2 = v[r][j].z * rstd[r] * g.z, h3 = v[r][j].w * rstd[r] * g.w;
            if (NOST) { ck += ((unsigned long long)pk2(h0, h1) | ((unsigned long long)pk2(h2, h3) << 32)) ^ pk4_fp8(h0, h1, h2, h3); } else {
            o8[(size_t)r * (DM / 4) + 64 * j] = (unsigned long long)pk2(h0, h1) | ((unsigned long long)pk2(h2, h3) << 32); o4[(size_t)r * (DM / 4) + 64 * j] = pk4_fp8(h0, h1, h2, h3); } } }
    if (NOST && ck == 0x123456789abcdefull) o8[0] = ck;
}
__device__ __forceinline__ void rms_gain(const Ptrs& P, int lane, f32x4 (&g)[8]) {
#pragma unroll
    for (int j = 0; j < 8; ++j) g[j] = ((const GAS f32x4*)P.norm_g)[lane + 64 * j];
}
template <int NR>
__device__ __forceinline__ void rms_rows(const Ptrs& P, int m0, int lane) {
    static_assert(NR == 4, "two pairs");
    f32x4 g[8], v[2][8]; rms_gain(P, lane, g);
    rms_load<2>(P, m0, lane, v); rms_store<2>(P, m0, lane, v, g);
    rms_load<2>(P, m0 + 2, lane, v); rms_store<2>(P, m0 + 2, lane, v, g);
}
constexpr int DF_CNT = 40000;
__device__ __forceinline__ int df_row(int g, int q) { return 256 * (12 * (q >> 9) + 2 * g + ((q >> 8) & 1)) + (q & 255); }
struct Args;
__device__ __forceinline__ const Ptrs& df_ptrs();
struct DfOrder {
    pg8::StaticOrder so; bool df;
    __device__ __forceinline__ bool next(int i, pg8::Unit& u) const {
        pg8::Unit t; t.pm = 0; t.pn = 0; const bool ok0 = so.next(i, t);
        const int xcd = blockIdx.x & 7, j = blockIdx.x >> 3;
        u.pm = df ? 12 * xcd + 2 * i + (j & 1) : t.pm; u.pn = df ? (j >> 1) : t.pn; u.ri = i;
        return df ? (i < 6) : ok0;
    }
    __device__ __forceinline__ void a_ready(const pg8::Unit&) const {}
    static __device__ __forceinline__ void produce(int g) {
        const Ptrs& P = df_ptrs();
        const int tid = threadIdx.x, lane = tid & 63, wave = __builtin_amdgcn_readfirstlane(tid >> 6), xcd = blockIdx.x & 7, j = blockIdx.x >> 3;
#ifdef PROBE_T
        if (tid == 0 && g == 3) ((unsigned long long*)(P.ws + WS_CTL + 800 * 1024))[64 + blockIdx.x * 16 + 13] = __builtin_amdgcn_s_memrealtime();
#endif
        const int q0 = ((xcd * 8 + (j & 7)) * 8 + wave) * 8;
        const int m0 = df_row(g, q0);
        f32x4 gn[8], va[2][8], vb[2][8]; rms_gain(P, lane, gn);
#ifdef PROBE_RD
        if (g == 3) { const int md = df_row(5, q0);
            rms_load<2>(P, md, lane, va); rms_load<2>(P, md + 2, lane, vb);
            rms_store<2, false, true>(P, md, lane, va, gn); rms_load<2>(P, md + 4, lane, va);
            rms_store<2, false, true>(P, md + 2, lane, vb, gn); rms_load<2>(P, md + 6, lane, vb);
            rms_store<2, false, true>(P, md + 4, lane, va, gn); rms_store<2, false, true>(P, md + 6, lane, vb, gn);
        }
#endif
        rms_load<2>(P, m0, lane, va); rms_load<2>(P, m0 + 2, lane, vb);
        rms_store<2>(P, m0, lane, va, gn); rms_load<2>(P, m0 + 4, lane, va);
        rms_store<2>(P, m0 + 2, lane, vb, gn); rms_load<2>(P, m0 + 6, lane, vb);
        rms_store<2>(P, m0 + 4, lane, va, gn); rms_store<2>(P, m0 + 6, lane, vb, gn);
        asm volatile("s_waitcnt vmcnt(0)" ::: "memory");
        __builtin_amdgcn_s_barrier();
#ifdef PROBE_T
        if (tid == 0 && g == 3) ((unsigned long long*)(P.ws + WS_CTL + 800 * 1024))[64 + blockIdx.x * 16 + 12] = __builtin_amdgcn_s_memrealtime();
#endif
        if (tid == 0) { __builtin_amdgcn_fence(__ATOMIC_RELEASE, "agent"); (void)xb_add((unsigned*)(P.ws + WS_CTL) + DF_CNT + 64 * g, 1u); }
    }
    static __device__ __forceinline__ void wait(int g) {
        if (threadIdx.x == 0) { unsigned* c = (unsigned*)(df_ptrs().ws + WS_CTL) + DF_CNT + 64 * g; unsigned sp = 0; while (xb_ld(c) < 64u) { __builtin_amdgcn_s_sleep(1); if (++sp > XB_SPIN_CAP) break; } }
        asm volatile("" ::: "memory");
        __builtin_amdgcn_s_barrier();
        asm volatile("" ::: "memory");
    }
    __device__ __forceinline__ void done(const pg8::Unit& u) const {
        if (!df) return;
        const int i = u.ri, j8 = blockIdx.x >> 6;
        if (DF_MODE == 0 && i <= 2 && j8 == i + 1) produce(i + 3);
        if (DF_MODE == 0 && i <= 3) wait(i + 2);
    }
};

#ifdef PROBE_T
__device__ int g_probe[3] = {PROBE_A, PROBE_B, PROBE_MODE};
__device__ float g_pscale = PROBE_SCALE;
#endif
struct Args { Ptrs P; int ph_lo, ph_hi, li, pad; };
__device__ __forceinline__ const Ptrs& df_ptrs() {
    const __attribute__((address_space(4))) Args* ka = (const __attribute__((address_space(4))) Args*)__builtin_amdgcn_kernarg_segment_ptr();
    asm volatile("" : "+s"(ka));
    return *(const Ptrs*)&((const Args*)ka)->P;
}
__global__ void __launch_bounds__(NWAVES * 64, 2) mega(Args args) {
    extern __shared__ __attribute__((aligned(16))) unsigned char lds[];
    LAS unsigned char* L = (LAS unsigned char*)lds;
    volatile LAS unsigned* MISC = (volatile LAS unsigned*)(L + MISC_OFF);
    const int tid = threadIdx.x, lane = tid & 63, wave = __builtin_amdgcn_readfirstlane(tid >> 6);
    const int G = gridDim.x; const int bx = blockIdx.x; const int vcu = (G % 8 == 0) ? (bx % 8) * (G / 8) + bx / 8 : bx;
    const Ptrs& P = args.P; unsigned char* ws = P.ws;
    gu32* ctl = (gu32*)(ws + WS_CTL);
    for (int u = tid; u < (LDS_BYTES - LDSCTL_OFF) / 4; u += NWAVES * 64) ((LAS unsigned*)(L + LDSCTL_OFF))[u] = 0u;
    __syncthreads();
    const int lo = args.ph_lo, hi = args.ph_hi;
    XcdBarrier bar; bar.bar = (unsigned*)(ctl + CW_BAR) + args.li * XCD_BAR_WORDS; bar.x = 0; bar.st = nullptr;
    if (hi - lo > 1) bar = xcd_barrier_post((unsigned*)(ctl + CW_BAR) + args.li * XCD_BAR_WORDS, MISC + 8);
#ifndef PH_ENABLE
#define PH_ENABLE 63
#endif
#ifndef REPEAT_MASK
#define REPEAT_MASK 0
#endif
#if REPEAT_MASK
#define REP(k) for (int rep_ = 0; rep_ < 1 + ((REPEAT_MASK >> (k)) & 1); ++rep_)
#else
#define REP(k)
#endif
#define IN(k) (((PH_ENABLE >> (k)) & 1) && lo <= (k) && (k) < hi)
#ifdef PROBE_T
    unsigned long long* TS = (unsigned long long*)(ws + WS_CTL + 800 * 1024);
#ifndef PROBE_BX
#define PROBE_BX 0
#endif
#define STAMP(k) do { if (tid == 0) { const unsigned long long t_ = __builtin_amdgcn_s_memrealtime(); TS[64 + bx * 16 + (k)] = t_; if (bx == PROBE_BX) { TS[k] = t_; TS[32 + (k)] = __builtin_amdgcn_s_memtime(); } } } while (0)
#else
#define STAMP(k)
#endif
    STAMP(0);
    const bool df = (G == 256) && IN(0) && IN(1);
    bf16_t* Hb = (bf16_t*)(ws + WS_H); bf16_t* WinT = (bf16_t*)(ws + WS_WIN); bf16_t* WabT = (bf16_t*)(ws + WS_WAB); bf16_t* WoT = (bf16_t*)(ws + WS_WO);

    if (IN(0)) {
        REP(0) {
        LAS float* scr = (LAS float*)(L + RING_OFF + wave * 16384);
        const int gw = vcu * NWAVES + wave, NGW = G * NWAVES;
        constexpr int I_IN = (DM / 64) * (NIN / 32), I_AB = (1024 / 64) * (DM / 32), I_O = (DM / 64) * (DM / 32);
        constexpr int NITEMS = I_IN + 2 * I_AB + I_O;
        for (int it = gw; it < (df ? I_IN : NITEMS); it += NGW) {
            int r = it;
            if (r < I_IN) { const int n0 = 32 * (r % (NIN / 32)), pn = n0 >> 8; const bool f8 = pg8::pn_is8(pn);
                p0_transpose_item(P.w_in, NIN, f8 ? (bf16_t*)(ws + WS_WIN8) : WinT, DM, 0,     (n0 >= C_GQQ && n0 < C_GQV) ? 2 : 1, scr, r, lane, pg8::pn_idx(pn) * 256, f8); continue; } r -= I_IN;
            if (r < I_AB) { p0_transpose_item(P.w_a, DM, WabT, 1536, 0, 1, scr, r, lane, -1, false); continue; } r -= I_AB;
            if (r < I_AB) { p0_transpose_item(P.w_b, DM, WabT, 3072, 2048, 1, scr, r, lane, -1, true); continue; } r -= I_AB;
            p0_transpose_item(P.w_out, DM, WoT, DM, 0, 0, scr, r, lane, -1, false);
        }
        if (df && DF_MODE == 0) { for (int q = 4 * gw; q < 8192; q += 4 * NGW) rms_rows<4>(P, df_row(q >> 12, q & 4095), lane); }
        else for (int m = 4 * gw; m < M; m += 4 * NGW) rms_rows<4>(P, m, lane);
        const int gt = vcu * (NWAVES * 64) + tid, NGT = G * NWAVES * 64;
        for (int i = gt; i < 128 * 32; i += NGT) { const int pos = i >> 5, f = i & 31; const float ang = (float)pos * powf(10000.0f, -(float)(2 * f) / 64.0f);
            float* T = (float*)(ws + WS_ROPE); T[i] = cosf(ang); T[4096 + i] = sinf(ang); }
        if (gt < 64) {
            const float gq = wave_max(fmaxf(fabsf(P.gq_q_g[lane]), fabsf(P.gq_q_g[lane + 64]))), gk = wave_max(fmaxf(fabsf(P.gq_k_g[lane]), fabsf(P.gq_k_g[lane + 64])));
            if (lane == 0) ((float*)(ws + WS_ROPE))[8192] = -(QSCALE * 128.0f * gq * gk);
        }
        {
            const float gq = wave_max(fmaxf(fabsf(P.na_q_g[lane]), fabsf(P.na_q_g[lane + 64]))), gk = wave_max(fmaxf(fabsf(P.na_k_g[lane]), fabsf(P.na_k_g[lane + 64])));
            const float Bna = QSCALE * 128.0f * gq * gk;
            f32x4* BT = (f32x4*)(ws + WS_BIAS);
            for (int e = gt; e < 8 * 15 * 2 * 8 * 64; e += NGT) {
                const int ln = e & 63, i = (e >> 6) & 7, half = (e >> 9) & 1, hd = e >> 10;
                const int c = 32 * half + (ln & 31), kc0 = (32 * (i >> 2) + 8 * (i & 3) + 4 * (ln >> 5) + 16 * half) & 63;
                int cs = c - 8; cs = cs < 0 ? 0 : (cs > 48 ? 48 : cs);
                f32x4 v;
#pragma unroll
                for (int q = 0; q < 4; ++q) { const int kc = kc0 + q; const bool valid = (kc >= cs) && (kc < cs + 16); const int idx = valid ? (kc - c + 15) : 15;
                    const float b = P.na_rpb[hd * 31 + idx] * LOG2E - Bna; v[q] = valid ? b : -30000.0f; }
                BT[e] = v;
            }
        }
        }
        STAMP(1);
        if (IN(1)) xcd_barrier(bar);
        STAMP(2);
    }
    if (IN(1)) {
        {   pg8::Gemm g{Hb, WinT, M, pg8::N16 * 256, DM}; DfOrder S; S.so.init(M, pg8::N16 * 256, G, bx); S.df = df;
            pg8::EpiA<false> E{P, (LAS float*)(L + XCH_OFF)};
            STAMP(10); STAMP(13); STAMP(12); if (DF_MODE == 0 && df && (bx >> 6) == 0) DfOrder::produce(2); STAMP(11);
            REP(1) pg8::gemm_phase<pg8::EpiA<false>, DfOrder, true, true, false>(L + RING_OFF, g, S, E); }
        {   pg8::Gemm g{(const bf16_t*)(ws + WS_H8), (const bf16_t*)(ws + WS_WIN8), M, pg8::N8 * 256, DM / 2}; pg8::StaticOrder S; S.init(M, pg8::N8 * 256, G, bx);
            pg8::EpiA<true> E{P, (LAS float*)(L + XCH_OFF)};
            REP(1) pg8::gemm_phase<pg8::EpiA<true>, pg8::StaticOrder, true, true, true>(L + RING_OFF, g, S, E); }
        if (df && bx >= 192) {
            LAS float* scr = (LAS float*)(L + RING_OFF + wave * 16384);
            constexpr int I_AB = (1024 / 64) * (DM / 32), I_O = (DM / 64) * (DM / 32);
            for (int r0 = (bx - 192) * NWAVES + wave; r0 < 2 * I_AB + I_O; r0 += 64 * NWAVES) { int r = r0;
                if (r < I_AB) { p0_transpose_item(P.w_a, DM, WabT, 1536, 0, 1, scr, r, lane, -1, false); continue; } r -= I_AB;
                if (r < I_AB) { p0_transpose_item(P.w_b, DM, WabT, 3072, 2048, 1, scr, r, lane, -1, true); continue; } r -= I_AB;
                p0_transpose_item(P.w_out, DM, WoT, DM, 0, 0, scr, r, lane, -1, false); }
        }
        STAMP(3);
        if (IN(2) || IN(3)) xcd_barrier(bar);
        STAMP(4);
    }
    if ((IN(2) || IN(3)) && wave >= 4) __builtin_amdgcn_s_setprio(3);
    if (IN(2)) {
        const bf16_t* QB = (const bf16_t*)(ws + WS_QB); const bf16_t* KB = (const bf16_t*)(ws + WS_KB); const bf16_t* VB = (const bf16_t*)(ws + WS_VB); const bf16_t* ZB = (const bf16_t*)(ws + WS_ZB);
        unsigned char* OB = ws + WS_OAB + 2048;
        const float negB = ((const float*)(ws + WS_ROPE))[8192];
        REP(2)
        for (int u = vcu; u < 768; u += G) {
            int h, seq; size_t t0, m0;
            if (u < 256) { h = u >> 5; t0 = 0; m0 = (size_t)(u & 31) * 256; seq = 8192; }
            else { const int s = u - 256; h = (s >> 3) & 7; t0 = (size_t)MP + (size_t)(s >> 6) * 2048; m0 = t0 + (size_t)(s & 7) * 256; seq = 2048; }
            att::gqa_unit((const unsigned char*)QB + m0 * 1024 + h * 128, (const unsigned char*)KB + t0 * 256 + (h >> 2) * 128, VB + t0 * 256 + (h >> 2) * 128, ZB + m0 * 1024 + h * 128, OB + m0 * 3072 + h * 128, seq, negB, (char*)lds);
        }
    }
    STAMP(5);
    if (IN(3)) {
        const bf16_t* QA = (const bf16_t*)(ws + WS_QA); const bf16_t* KA = (const bf16_t*)(ws + WS_KA); const bf16_t* VA = (const bf16_t*)(ws + WS_VA); const bf16_t* ZA = (const bf16_t*)(ws + WS_ZA);
        unsigned char* OA = ws + WS_OAB;
        REP(3)
        for (int n = vcu; n < 768; n += G) { const int h = (n >> 5) & 7, tb = (n >> 8) * 32 + (n & 31), m0 = tb * 256;
            const int s0 = m0 < MP ? 0 : MP + (((m0 - MP) >> 11) << 11), R = m0 < MP ? 128 : 32;
            att::na_unit(QA, KA, VA, ZA, OA, (const float*)(ws + WS_BIAS), m0, s0, R, h, (char*)lds); }
        __syncthreads();
    }
    __builtin_amdgcn_s_setprio(0);
    STAMP(6);
    if ((IN(2) || IN(3)) && IN(4)) xcd_barrier(bar);
    STAMP(7);
    if (IN(4)) {
        pg8::Gemm g{(const bf16_t*)(ws + WS_OAB), WabT, M, DM, 1536}; pg8::StaticOrder S; S.init(M, DM, G, bx);
        pg8::EpiC1 E{(const bf16_t*)P.out, (const unsigned char*)P.out + (size_t)M * DM * 2, (bf16_t*)(ws + WS_MG)};
        REP(4) pg8::gemm_phase<pg8::EpiC1, pg8::StaticOrder, true, true, false, true>(L + RING_OFF, g, S, E);
        STAMP(8);
        if (IN(5)) xcd_barrier(bar);
#ifdef DOUBLE_BAR
        if (IN(5)) { for (int q_ = 0; q_ < DOUBLE_BAR; ++q_) xcd_barrier(bar); }
#endif
        STAMP(9);
    }
    if (IN(5)) {
        pg8::Gemm g{(const bf16_t*)(ws + WS_MG), WoT, M, DM, DM}; pg8::StaticOrder S; S.init(M, DM, G, bx);
#ifdef PROBE_T
        float pscale = 1.0f;
        {   const int ka = g_probe[0], kb = g_probe[1], mode = g_probe[2];
            if (mode == 0) pscale = 1.0f + (float)(TS[64 + ka] - TS[64 + kb]) * g_pscale;
            else if (mode == 1 || mode == 2) { unsigned long long acc_ = mode == 1 ? 0ull : ~0ull;
                for (int b = 0; b < G; ++b) { const unsigned long long d = TS[64 + b * 16 + ka] - TS[64 + b * 16 + kb]; acc_ = mode == 1 ? (d > acc_ ? d : acc_) : (d < acc_ ? d : acc_); }
                pscale = 1.0f + (float)acc_ * g_pscale; }
            else if (mode == 4) pscale = 1.0f + (float)(TS[32 + 3] - TS[32 + 2]) / (float)(TS[3] - TS[2]) * 1e-3f; }
        pg8::EpiC2 E{P.xp, P.xs, P.out, pscale};
#else
        pg8::EpiC2 E{P.xp, P.xs, P.out, 1.0f};
#endif
        REP(5) pg8::gemm_phase<pg8::EpiC2, pg8::StaticOrder, true, true>(L + RING_OFF, g, S, E);
#if defined(PROBE_T)
        if (bx == 0 && g_probe[2] == 3) {
            __syncthreads();
            if (tid == 0) TS[64 + 10] = __builtin_amdgcn_s_memrealtime();
            asm volatile("s_waitcnt vmcnt(0)" ::: "memory"); __syncthreads();
            const float sc2 = 1.0f + (float)(TS[64 + g_probe[0]] - TS[64 + g_probe[1]]) * g_pscale;
            pg8::Unit lu; int nu = 0; while (S.next(nu, lu)) ++nu; S.next(nu - 1, lu);
            for (int e = tid; e < 256 * 256; e += NWAVES * 64) { float* p = P.out + (size_t)(lu.pm * 256 + (e >> 8)) * DM + lu.pn * 256 + (e & 255); *p = *p * sc2; }
        }
#endif
    }
#undef IN
}

extern "C" void kernel_launch(void* const* d_in, const int* in_sizes, int n_in, void* d_out, int out_size, void* d_ws, size_t ws_size, hipStream_t stream) {
    static int grid = 0;
    if (grid == 0) {
        if (n_in != 13 || in_sizes[0] != MP * DM || in_sizes[1] != MS * DM || in_sizes[3] != DM * NIN || out_size != M * DM || ws_size < WS_END) {
            fprintf(stderr, "kernel_launch: shape mismatch n_in %d out %d ws %zu (need %zu)\n", n_in, out_size, ws_size, (size_t)WS_END); grid = -1; return; }
        int dev = 0, cus = 0, per_cu = 0;
        if (hipGetDevice(&dev) != hipSuccess || hipDeviceGetAttribute(&cus, hipDeviceAttributeMultiprocessorCount, dev) != hipSuccess) { fprintf(stderr, "kernel_launch: device query failed\n"); grid = -1; return; }
        if (hipFuncSetAttribute((const void*)mega, hipFuncAttributeMaxDynamicSharedMemorySize, LDS_BYTES) != hipSuccess) { fprintf(stderr, "kernel_launch: hipFuncSetAttribute failed\n"); grid = -1; return; }
        if (hipOccupancyMaxActiveBlocksPerMultiprocessor(&per_cu, (const void*)mega, NWAVES * 64, LDS_BYTES) != hipSuccess || per_cu < 1) { fprintf(stderr, "kernel_launch: occupancy query says %d blocks per CU\n", per_cu); }
        (void)hipGetLastError();
        grid = cus;
    }
    if (grid < 0) return;
    Ptrs P{};
    P.xp = (const float*)d_in[0]; P.xs = (const float*)d_in[1]; P.norm_g = (const float*)d_in[2]; P.w_in = (const float*)d_in[3];
    P.na_q_g = (const float*)d_in[4]; P.na_k_g = (const float*)d_in[5]; P.na_rpb = (const float*)d_in[6]; P.gq_q_g = (const float*)d_in[7]; P.gq_k_g = (const float*)d_in[8];
    P.w_a = (const float*)d_in[9]; P.w_b = (const float*)d_in[10]; P.gate_bias = (const float*)d_in[11]; P.w_out = (const float*)d_in[12];
    P.out = (float*)d_out; P.ws = (unsigned char*)d_ws;
    (void)hipMemsetAsync((char*)d_ws + WS_CTL, 0, CTL_ZERO_BYTES, stream);
    Args a{}; a.P = P; a.ph_lo = 0; a.ph_hi = 6; a.li = 0;
    hipLaunchKernelGGL(mega, dim3(grid), dim3(NWAVES * 64), LDS_BYTES, stream, a);
    const hipError_t le = hipPeekAtLastError();
    if (le != hipSuccess) fprintf(stderr, "kernel_launch: launch failed: %s\n", hipGetErrorName(le));
}
```
